# Optimizing an MI355X kernel written in HIP

```python
import jax, jax.numpy as jnp
from jax import lax
import numpy as np

D_MODEL = 1024
BATCH = 1
SEQ = 16384
DEPTH = 1
DEC_BATCH = 128
DEC_SEQ = 1
PAST_LEN = 16384
PAGE_SIZE = 128

D_MIX = D_MODEL
D_ATTN = D_MIX // 2
D_POOL = D_MIX - D_ATTN
HEAD_DIM = 64
N_HEADS = D_ATTN // HEAD_DIM
N_KV_HEADS = 2
GROUP = N_HEADS // N_KV_HEADS
D_KV = N_KV_HEADS * HEAD_DIM
WINDOW = 128
BLOCK = 128
POOL_WINDOWS = (2, 4, 8, 16)
N_POOL_GROUPS = len(POOL_WINDOWS)
POOL_GROUP_DIM = D_POOL // N_POOL_GROUPS
POOL_STATE = max(POOL_WINDOWS) - 1
D_IN_PROJ = D_ATTN + 2 * D_KV + D_ATTN + D_POOL + D_POOL
EPS = 1e-6
NEG_INF = -1e30

kernel_name = "hymba_swa_sink_pool_hybrid_step"


def _rms(x, w):
    xf = x.astype(jnp.float32)
    r = xf * lax.rsqrt(jnp.mean(xf * xf, axis=-1, keepdims=True) + EPS)
    return (r * w.astype(jnp.float32)).astype(x.dtype)


def _project(x, norm_w, w_in, q_norm_w, k_norm_w):
    B, T = x.shape[0], x.shape[1]
    z = _rms(x, norm_w) @ w_in
    o1 = D_ATTN
    o2 = o1 + D_KV
    o3 = o2 + D_KV
    o4 = o3 + D_ATTN
    o5 = o4 + D_POOL
    q = _rms(z[..., :o1].reshape(B, T, N_KV_HEADS, GROUP, HEAD_DIM), q_norm_w)
    k = _rms(z[..., o1:o2].reshape(B, T, N_KV_HEADS, HEAD_DIM), k_norm_w)
    v = z[..., o2:o3].reshape(B, T, N_KV_HEADS, HEAD_DIM)
    g_a = z[..., o3:o4]
    u = z[..., o4:o5]
    g_p = z[..., o5:]
    return q, k, v, g_a, u, g_p


def _sink_attn(q, k, v, q_pos, k_pos, sinks):
    s = jnp.einsum('bqkgd,bskd->bkgqs', q, k).astype(jnp.float32) * (HEAD_DIM ** -0.5)
    rel = q_pos[:, None] - k_pos[None, :]
    valid = (rel >= 0) & (rel <= WINDOW) & (k_pos[None, :] >= 0)
    s = jnp.where(valid, s, NEG_INF)
    sink = jnp.broadcast_to(sinks.astype(jnp.float32).reshape(N_KV_HEADS, GROUP, 1, 1),
                            s.shape[:-1] + (1,))
    p = jax.nn.softmax(jnp.concatenate([s, sink], axis=-1), axis=-1)[..., :-1]
    return jnp.einsum('bkgqs,bskd->bqkgd', p.astype(v.dtype), v)


def _attn_prompt(q, k, v, sinks):
    B, T = q.shape[0], q.shape[1]
    nb = T // BLOCK
    qb = q.reshape(B, nb, BLOCK, N_KV_HEADS, GROUP, HEAD_DIM)
    kb = k.reshape(B, nb, BLOCK, N_KV_HEADS, HEAD_DIM)
    vb = v.reshape(B, nb, BLOCK, N_KV_HEADS, HEAD_DIM)
    pad = ((0, 0), (1, 0), (0, 0), (0, 0), (0, 0))
    kk = jnp.concatenate([jnp.pad(kb, pad)[:, :-1], kb], axis=2)
    vv = jnp.concatenate([jnp.pad(vb, pad)[:, :-1], vb], axis=2)
    start = jnp.arange(nb, dtype=jnp.int32) * BLOCK
    q_pos = start[:, None] + jnp.arange(BLOCK, dtype=jnp.int32)[None, :]
    k_pos = start[:, None] - BLOCK + jnp.arange(2 * BLOCK, dtype=jnp.int32)[None, :]
    o = jax.vmap(_sink_attn, in_axes=(1, 1, 1, 0, 0, None), out_axes=1)(qb, kk, vv, q_pos, k_pos, sinks)
    return o.reshape(B, T, D_ATTN)


def _attn_sample(q, k, v, cache_k, cache_v, sinks):
    B, T = q.shape[0], q.shape[1]
    wc = cache_k.shape[1]
    kk = jnp.concatenate([cache_k.astype(k.dtype), k], axis=1)
    vv = jnp.concatenate([cache_v.astype(v.dtype), v], axis=1)
    q_pos = PAST_LEN + jnp.arange(T, dtype=jnp.int32)
    k_pos = PAST_LEN - wc + jnp.arange(wc + T, dtype=jnp.int32)
    o = _sink_attn(q, kk, vv, q_pos, k_pos, sinks)
    return o.reshape(B, T, D_ATTN), kk[:, -wc:], vv[:, -wc:]


def _pool(u_ext, pos0, w_pool, pool_scale):
    B = u_ext.shape[0]
    P = POOL_STATE
    T = u_ext.shape[1] - P
    uf = u_ext.astype(jnp.float32)
    cs = jnp.concatenate([jnp.zeros((B, 1, D_POOL), jnp.float32), jnp.cumsum(uf, axis=1)], axis=1)
    pos = pos0 + jnp.arange(T, dtype=jnp.int32)
    u_tok = uf[:, P:]
    outs = []
    for gi, w in enumerate(POOL_WINDOWS):
        lo, hi = gi * POOL_GROUP_DIM, (gi + 1) * POOL_GROUP_DIM
        win = cs[:, P + 1:P + 1 + T, lo:hi] - cs[:, P + 1 - w:P + 1 - w + T, lo:hi]
        cnt = jnp.minimum(w, pos + 1).astype(jnp.float32)[None, :, None]
        outs.append(win / cnt - u_tok[..., lo:hi])
    d = jnp.stack(outs, axis=2)
    y = jnp.einsum('btgc,gcd->btgd', d, w_pool.astype(jnp.float32)).reshape(B, T, D_POOL)
    return (y * pool_scale.astype(jnp.float32)).astype(u_ext.dtype)


def _merge(x, attn_o, g_a, pool_o, g_p, w_out):
    mixed = jnp.concatenate([attn_o * jax.nn.silu(g_a), pool_o * jax.nn.silu(g_p)], axis=-1)
    return x + mixed @ w_out


def setup_inputs(seed: int = 0) -> dict:
    key = jax.random.key(seed)
    ks = jax.random.split(key, 16)
    f32 = jnp.float32
    return {
        "x_prompt": jax.random.normal(ks[0], (BATCH, SEQ, D_MODEL), f32),
        "x_sample": jax.random.normal(ks[1], (DEC_BATCH, DEC_SEQ, D_MODEL), f32),
        "cache_k": jax.random.normal(ks[2], (DEPTH, DEC_BATCH, WINDOW, N_KV_HEADS, HEAD_DIM), f32),
        "cache_v": jax.random.normal(ks[3], (DEPTH, DEC_BATCH, WINDOW, N_KV_HEADS, HEAD_DIM), f32),
        "state_pool": jax.random.normal(ks[4], (DEPTH, DEC_BATCH, POOL_STATE, D_POOL), f32),
        "norm_w": 1.0 + 0.02 * jax.random.normal(ks[5], (DEPTH, D_MODEL), f32),
        "w_in": jax.random.normal(ks[6], (DEPTH, D_MODEL, D_IN_PROJ), f32) * D_MODEL ** -0.5,
        "q_norm_w": 1.0 + 0.02 * jax.random.normal(ks[7], (DEPTH, HEAD_DIM), f32),
        "k_norm_w": 1.0 + 0.02 * jax.random.normal(ks[8], (DEPTH, HEAD_DIM), f32),
        "sinks": 0.5 * jax.random.normal(ks[9], (DEPTH, N_HEADS), f32),
        "w_pool": jax.random.normal(ks[10], (DEPTH, N_POOL_GROUPS, POOL_GROUP_DIM, POOL_GROUP_DIM), f32) * POOL_GROUP_DIM ** -0.5,
        "pool_scale": 1.0 + 0.02 * jax.random.normal(ks[11], (DEPTH, D_POOL), f32),
        "w_out": jax.random.normal(ks[12], (DEPTH, D_MIX, D_MODEL), f32) * D_MIX ** -0.5,
    }


def reference(x_prompt, x_sample, cache_k, cache_v, state_pool, norm_w, w_in, q_norm_w,
              k_norm_w, sinks, w_pool, pool_scale, w_out):
    hp, hs = x_prompt, x_sample
    kp, vp, pp, kq, vq, pq = [], [], [], [], [], []
    for l in range(DEPTH):
        q, k, v, g_a, u, g_p = _project(hp, norm_w[l], w_in[l], q_norm_w[l], k_norm_w[l])
        a_o = _attn_prompt(q, k, v, sinks[l])
        u_ext = jnp.pad(u, ((0, 0), (POOL_STATE, 0), (0, 0)))
        p_o = _pool(u_ext, 0, w_pool[l], pool_scale[l])
        kp.append(k[:, -WINDOW:])
        vp.append(v[:, -WINDOW:])
        pp.append(u_ext[:, -POOL_STATE:])
        hp = _merge(hp, a_o, g_a, p_o, g_p, w_out[l])
        q, k, v, g_a, u, g_p = _project(hs, norm_w[l], w_in[l], q_norm_w[l], k_norm_w[l])
        a_o, k_new, v_new = _attn_sample(q, k, v, cache_k[l], cache_v[l], sinks[l])
        u_ext = jnp.concatenate([state_pool[l].astype(u.dtype), u], axis=1)
        p_o = _pool(u_ext, PAST_LEN, w_pool[l], pool_scale[l])
        kq.append(k_new)
        vq.append(v_new)
        pq.append(u_ext[:, -POOL_STATE:])
        hs = _merge(hs, a_o, g_a, p_o, g_p, w_out[l])
    return (hp, hs, jnp.stack(kp), jnp.stack(vp), jnp.stack(pp), jnp.stack(kq), jnp.stack(vq), jnp.stack(pq))
```

```cpp
#include <hip/hip_runtime.h>
#include <cstdio>
#include <cstdint>
#ifndef ONE_LAUNCH
#define ONE_LAUNCH 1
#endif
namespace pg8 {
#define PG8_LAS __attribute__((address_space(3)))
typedef unsigned short bf16_t;
typedef short bf16x8 __attribute__((ext_vector_type(8)));
typedef float f32x4 __attribute__((ext_vector_type(4)));
typedef unsigned u32x4 __attribute__((ext_vector_type(4)));
constexpr int BM = 256, BK = 64, HALF = 128, HTB = HALF * BK * 2  , STAGE_BYTES = 8 * HTB, NXCD = 8, WGM = 8;

__host__ __device__ __forceinline__ int lds_byte(int r, int c) { const int st = (r >> 4) * 2 + (c >> 5), rr = r & 15, cc = c & 31, ob = rr * 64 + cc * 2; return st * 1024 + (ob ^ (((ob >> 9) & 1) << 5)); }
__host__ __device__ __forceinline__ void stage_rc(int b, int& R, int& C) { const int st = b / 1024, sb = b % 1024, swz = sb ^ (((sb >> 9) & 1) << 5); R = (st >> 1) * 16 + swz / 64; C = (st & 1) * 32 + (swz % 64) / 2; }
__host__ __device__ __forceinline__ int perm32(int rho) { const int n = rho >> 4, i = rho & 15; return 8 * (i >> 2) + 4 * n + (i & 3); }

struct Unit { int pm, pn; };
struct Gemm { const bf16_t* A; const bf16_t* Bt; int M, N, K; };

struct StaticOrder {
    int nM, nN, nwg, G, c;
    __host__ __device__ void init(int M, int N, int G_, int c_) { nM = M / BM; nN = N / BM; nwg = nM * nN; G = G_; c = c_; }
    __host__ __device__ bool next(int i, Unit& u) const {
        const long L = (long)i * G + c; if (L >= nwg) return false;
        int wgid = (int)L; { const int q = nwg / NXCD, r = nwg % NXCD, xcd = wgid % NXCD, off = wgid / NXCD; wgid = (xcd < r ? xcd * (q + 1) : r * (q + 1) + (xcd - r) * q) + off; }
        const int nig = WGM * nN, gid = wgid / nig, fm = gid * WGM, gsz = (nM - fm) < WGM ? (nM - fm) : WGM;
        u.pm = fm + ((wgid % nig) % gsz); u.pn = (wgid % nig) / gsz; return true;
    }
    __device__ __forceinline__ void a_ready(const Unit&) const {}
    __device__ __forceinline__ void done(const Unit&) const {}
};

__device__ __forceinline__ unsigned cvt_pk_bf16(float lo, float hi) { unsigned r; asm volatile("v_cvt_pk_bf16_f32 %0, %1, %2" : "=v"(r) : "v"(lo), "v"(hi)); return r; }
struct EpiZ {
    static constexpr bool PERM = true, AFTER_DRAIN = false;
    bf16_t* Z; int ldc; const float* rstd; bf16_t* VT; int vt_ld;
    __device__ __forceinline__ void operator()(const f32x4 (&acc)[2][2][4][2], const Unit& u, int wr, int wc, int fr, int fq) const {
        const int row0 = u.pm * BM + wr * 64 + fr, col0 = u.pn * BM + wc * 32 + 8 * fq;
        const bool gate = (u.pn == 3) | (u.pn == 4) | (u.pn >= 7);
#pragma unroll
        for (int ai = 0; ai < 2; ++ai)
#pragma unroll
            for (int m = 0; m < 4; ++m) {
                const int row = row0 + ai * HALF + m * 16;
                bf16_t* rowp = Z + (size_t)row * ldc + col0;
#pragma unroll
                for (int bj = 0; bj < 2; ++bj) { f32x4 v0 = acc[ai][bj][m][0], v1 = acc[ai][bj][m][1];
                    if (gate) {
#pragma unroll
                        for (int j = 0; j < 4; ++j) { v0[j] = v0[j] * __builtin_amdgcn_rcpf(1.0f + __builtin_amdgcn_exp2f(v0[j] * -1.4426950408889634f)); v1[j] = v1[j] * __builtin_amdgcn_rcpf(1.0f + __builtin_amdgcn_exp2f(v1[j] * -1.4426950408889634f)); } }
                    u32x4 w; w.x = cvt_pk_bf16(v0[0], v0[1]); w.y = cvt_pk_bf16(v0[2], v0[3]); w.z = cvt_pk_bf16(v1[0], v1[1]); w.w = cvt_pk_bf16(v1[2], v1[3]);
                    *(u32x4*)(rowp + bj * HALF) = w;
                    if (bj == 1 && u.pn == 2) {
                        bf16_t* vt = VT + (size_t)(wc * 32 + 8 * fq) * vt_ld + row;
                        vt[0 * (size_t)vt_ld] = (bf16_t)(w.x & 0xffffu); vt[1 * (size_t)vt_ld] = (bf16_t)(w.x >> 16);
                        vt[2 * (size_t)vt_ld] = (bf16_t)(w.y & 0xffffu); vt[3 * (size_t)vt_ld] = (bf16_t)(w.y >> 16);
                        vt[4 * (size_t)vt_ld] = (bf16_t)(w.z & 0xffffu); vt[5 * (size_t)vt_ld] = (bf16_t)(w.z >> 16);
                        vt[6 * (size_t)vt_ld] = (bf16_t)(w.w & 0xffffu); vt[7 * (size_t)vt_ld] = (bf16_t)(w.w >> 16);
                    } } }
    }
};
struct EpiRes {
    static constexpr bool PERM = false, AFTER_DRAIN = false;
    const float* base; float* out; int ldc; int pre_pm, pre_pn;
    __device__ __forceinline__ void operator()(const f32x4 (&acc)[2][2][4][2], const Unit& u, int wr, int wc, int fr, int fq) const {
        const int row0 = u.pm * BM + wr * 64 + fr, col0 = u.pn * BM + wc * 32 + 4 * fq;
        if (u.pm == pre_pm && u.pn == pre_pn) {
#pragma unroll
            for (int ai = 0; ai < 2; ++ai)
#pragma unroll
                for (int m = 0; m < 4; ++m) { const size_t off = (size_t)(row0 + ai * HALF + m * 16) * ldc + col0;
#pragma unroll
                    for (int bj = 0; bj < 2; ++bj)
#pragma unroll
                        for (int n = 0; n < 2; ++n) __builtin_nontemporal_store(acc[ai][bj][m][n], (f32x4*)(out + off + bj * HALF + n * 16)); }
            return;
        }
#pragma unroll
        for (int ai = 0; ai < 2; ++ai) {
            f32x4 xv[4][2][2];
#pragma unroll
            for (int m = 0; m < 4; ++m) { const size_t off = (size_t)(row0 + ai * HALF + m * 16) * ldc + col0;
#pragma unroll
                for (int bj = 0; bj < 2; ++bj)
#pragma unroll
                    for (int n = 0; n < 2; ++n) xv[m][bj][n] = *(const f32x4*)(base + off + bj * HALF + n * 16); }
#pragma unroll
            for (int m = 0; m < 4; ++m) { const size_t off = (size_t)(row0 + ai * HALF + m * 16) * ldc + col0;
#pragma unroll
                for (int bj = 0; bj < 2; ++bj)
#pragma unroll
                    for (int n = 0; n < 2; ++n) *(f32x4*)(out + off + bj * HALF + n * 16) = xv[m][bj][n] + acc[ai][bj][m][n]; }
        }
    }
};
template <class Epi, class Sched, bool ALIGN_EPI = false, bool SP2 = false, bool PRE = false>
__device__ __forceinline__ void gemm_phase(PG8_LAS unsigned char* lds, const Gemm g, const Sched& S, const Epi& E, f32x4 (&acc)[2][2][4][2]) {
    int tid_ = threadIdx.x; asm volatile("" : "+v"(tid_));
    const int tid = tid_, wid = __builtin_amdgcn_readfirstlane(tid >> 6), lane = tid & 63, wr = wid >> 2, wc = wid & 3, fr = lane & 15, fq = lane >> 4;
    const int K = g.K, nt = K / BK;
    unsigned voffA[2], voffB[2];
#pragma unroll
    for (int i = 0; i < 2; ++i) { int R, C; stage_rc(tid * 16 + i * 8192, R, C); const int Rb = Epi::PERM ? ((R & ~31) + perm32(R & 31)) : R;
        voffA[i] = (unsigned)(R * K + C) * 2u; voffB[i] = (unsigned)(Rb * K + C) * 2u; }
    const size_t kstep = (size_t)(BK * 2);
    const size_t hstep = (size_t)HALF * K * 2;
    const size_t tstep = 2 * hstep;
    const unsigned ldsw = (unsigned)wid * 1024u;
    const int aoff = lds_byte(wr * 64 + fr, fq * 8), boff = lds_byte(wc * 32 + fr, fq * 8);
#define PG8_SA(b, h) (((b) * 2 + (h)) * HTB)
#define PG8_SB(b, h) ((4 + (b) * 2 + (h)) * HTB)
#define PG8_STAGE(bufoff, gbase, voff) do { _Pragma("unroll") for (int _i = 0; _i < 2; ++_i) \
        __builtin_amdgcn_global_load_lds((const unsigned*)((const char*)(gbase) + (voff)[_i]), (PG8_LAS unsigned*)(lds + (bufoff) + ldsw + _i * 8192), 16, 0, 0); } while (0)
#define PG8_LDA(dst, b, h) do { _Pragma("unroll") for (int m = 0; m < 4; ++m) _Pragma("unroll") for (int k = 0; k < 2; ++k) dst[m][k] = *(const PG8_LAS bf16x8*)(lds + PG8_SA(b, h) + aoff + m * 2048 + k * 1024); } while (0)
#define PG8_LDB(dst, b, h) do { _Pragma("unroll") for (int n = 0; n < 2; ++n) _Pragma("unroll") for (int k = 0; k < 2; ++k) dst[n][k] = *(const PG8_LAS bf16x8*)(lds + PG8_SB(b, h) + boff + n * 2048 + k * 1024); } while (0)
#define PG8_MMA(ai, bj, At, Bt) do { __builtin_amdgcn_s_setprio(1); _Pragma("unroll") for (int m = 0; m < 4; ++m) _Pragma("unroll") for (int n = 0; n < 2; ++n) _Pragma("unroll") for (int k = 0; k < 2; ++k) \
        acc[ai][bj][m][n] = __builtin_amdgcn_mfma_f32_16x16x32_bf16(Bt[n][k], At[m][k], acc[ai][bj][m][n], 0, 0, 0); __builtin_amdgcn_s_setprio(0); } while (0)
#define PG8_WAIT_V(n) asm volatile("s_waitcnt vmcnt(" #n ")" ::: "memory")
#define PG8_WAIT_L(n) asm volatile("s_waitcnt lgkmcnt(" #n ")" ::: "memory")
#define PG8_BAR __builtin_amdgcn_s_barrier()
#define PG8_SCHED __builtin_amdgcn_sched_barrier(0)
    Unit cur, nxt; int ui = 0;
    if (!S.next(0, cur)) return;
#pragma unroll
    for (int a = 0; a < 2; ++a)
#pragma unroll
        for (int b = 0; b < 2; ++b)
#pragma unroll
            for (int m = 0; m < 4; ++m)
#pragma unroll
                for (int n = 0; n < 2; ++n) { if constexpr (PRE) asm volatile("" : "+v"(acc[a][b][m][n]));
                                              else acc[a][b][m][n] = (f32x4){0.f, 0.f, 0.f, 0.f}; }
    bf16x8 At[4][2], B0[2][2], B1[2][2];
    const char* cA = (const char*)g.A + (size_t)cur.pm * tstep; const char* cB = (const char*)g.Bt + (size_t)cur.pn * tstep;
    S.a_ready(cur);
    if constexpr (SP2) {
        PG8_STAGE(PG8_SB(0, 0), cB, voffB); PG8_STAGE(PG8_SB(0, 1), cB + hstep, voffB); PG8_STAGE(PG8_SA(0, 0), cA, voffA); PG8_STAGE(PG8_SA(0, 1), cA + hstep, voffA);
        if (wr == 1) PG8_BAR;
        PG8_WAIT_V(2); PG8_BAR;
        PG8_STAGE(PG8_SB(1, 0), cB + kstep, voffB); PG8_STAGE(PG8_SA(1, 0), cA + kstep, voffA); PG8_STAGE(PG8_SB(1, 1), cB + hstep + kstep, voffB);
        PG8_WAIT_V(6); PG8_BAR;
    } else {
        PG8_STAGE(PG8_SB(0, 0), cB, voffB); PG8_STAGE(PG8_SA(0, 0), cA, voffA); PG8_STAGE(PG8_SB(0, 1), cB + hstep, voffB); PG8_STAGE(PG8_SA(0, 1), cA + hstep, voffA);
        if (wr == 1) PG8_BAR;
        PG8_WAIT_V(4); PG8_BAR;
        PG8_STAGE(PG8_SB(1, 0), cB + kstep, voffB); PG8_STAGE(PG8_SA(1, 0), cA + kstep, voffA); PG8_STAGE(PG8_SB(1, 1), cB + hstep + kstep, voffB);
        PG8_WAIT_V(6); PG8_BAR;
    }
    for (;;) {
        const bool has_next = S.next(ui + 1, nxt);
        const char* nA = has_next ? (const char*)g.A + (size_t)nxt.pm * tstep : cA; const char* nB = has_next ? (const char*)g.Bt + (size_t)nxt.pn * tstep : cB;
        for (int t = 0; t < nt; t += 2) {
            const bool last = (t == nt - 2);
            const char* a1 = cA + (size_t)(t + 1) * kstep;
            const char* a2 = last ? nA : cA + (size_t)(t + 2) * kstep; const char* b2 = last ? nB : cB + (size_t)(t + 2) * kstep;
            const char* a3 = a2 + kstep; const char* b3 = b2 + kstep;
            if (last && has_next) S.a_ready(nxt);
            if constexpr (SP2) {
            PG8_LDB(B0, 0, 0); PG8_LDB(B1, 0, 1); PG8_SCHED; PG8_LDA(At, 0, 0); PG8_STAGE(PG8_SA(1, 1), a1 + hstep, voffA);
            PG8_WAIT_V(8); PG8_WAIT_L(0); PG8_BAR; PG8_MMA(0, 0, At, B0); PG8_MMA(0, 1, At, B1); PG8_BAR; PG8_SCHED;
            PG8_LDA(At, 0, 1); PG8_STAGE(PG8_SB(0, 0), b2, voffB); PG8_STAGE(PG8_SB(0, 1), b2 + hstep, voffB); PG8_STAGE(PG8_SA(0, 0), a2, voffA);
            PG8_WAIT_V(8); PG8_WAIT_L(0); PG8_BAR; PG8_MMA(1, 0, At, B0); PG8_MMA(1, 1, At, B1); PG8_BAR; PG8_SCHED;
            PG8_LDB(B0, 1, 0); PG8_LDB(B1, 1, 1); PG8_SCHED; PG8_LDA(At, 1, 0); PG8_STAGE(PG8_SA(0, 1), a2 + hstep, voffA);
            PG8_WAIT_V(8); PG8_WAIT_L(0); PG8_BAR; PG8_MMA(0, 0, At, B0); PG8_MMA(0, 1, At, B1); PG8_BAR; PG8_SCHED;
            PG8_LDA(At, 1, 1); PG8_STAGE(PG8_SB(1, 0), b3, voffB); PG8_STAGE(PG8_SB(1, 1), b3 + hstep, voffB); PG8_STAGE(PG8_SA(1, 0), a3, voffA);
            PG8_WAIT_V(8); PG8_WAIT_L(0); PG8_BAR; PG8_MMA(1, 0, At, B0); PG8_MMA(1, 1, At, B1); PG8_BAR; PG8_SCHED;
            } else {
            PG8_LDB(B0, 0, 0); PG8_SCHED; PG8_LDA(At, 0, 0); PG8_STAGE(PG8_SA(1, 1), a1 + hstep, voffA);
            PG8_WAIT_L(8); PG8_BAR; PG8_WAIT_L(0); PG8_MMA(0, 0, At, B0); PG8_BAR; PG8_SCHED;
            PG8_LDB(B1, 0, 1); PG8_STAGE(PG8_SB(0, 0), b2, voffB);
            PG8_BAR; PG8_WAIT_L(0); PG8_MMA(0, 1, At, B1); PG8_BAR;
            PG8_LDA(At, 0, 1); PG8_STAGE(PG8_SA(0, 0), a2, voffA);
            PG8_BAR; PG8_WAIT_L(0); PG8_MMA(1, 0, At, B0); PG8_BAR; PG8_SCHED;
            PG8_STAGE(PG8_SB(0, 1), b2 + hstep, voffB);
            PG8_WAIT_V(6); PG8_BAR; PG8_MMA(1, 1, At, B1); PG8_BAR;
            PG8_LDB(B0, 1, 0); PG8_SCHED; PG8_LDA(At, 1, 0); PG8_STAGE(PG8_SA(0, 1), a2 + hstep, voffA);
            PG8_WAIT_L(8); PG8_BAR; PG8_WAIT_L(0); PG8_MMA(0, 0, At, B0); PG8_BAR; PG8_SCHED;
            PG8_LDB(B1, 1, 1); PG8_STAGE(PG8_SB(1, 0), b3, voffB);
            PG8_BAR; PG8_WAIT_L(0); PG8_MMA(0, 1, At, B1); PG8_BAR;
            PG8_LDA(At, 1, 1); PG8_STAGE(PG8_SA(1, 0), a3, voffA);
            PG8_BAR; PG8_WAIT_L(0); PG8_MMA(1, 0, At, B0); PG8_BAR; PG8_SCHED;
            PG8_STAGE(PG8_SB(1, 1), b3 + hstep, voffB);
            PG8_WAIT_V(6); PG8_BAR; PG8_MMA(1, 1, At, B1); PG8_BAR;
            }
        }
        if constexpr (ALIGN_EPI) { if (wr == 0) PG8_BAR; }
        if constexpr (!Epi::AFTER_DRAIN) { E(acc, cur, wr, wc, fr, fq); S.done(cur); }
        if (!has_next) break;
#pragma unroll
        for (int a = 0; a < 2; ++a)
#pragma unroll
            for (int b = 0; b < 2; ++b)
#pragma unroll
                for (int m = 0; m < 4; ++m)
#pragma unroll
                    for (int n = 0; n < 2; ++n) acc[a][b][m][n] = (f32x4){0.f, 0.f, 0.f, 0.f};
        cur = nxt; cA = nA; cB = nB; ++ui;
        if constexpr (ALIGN_EPI) { if (wr == 1) PG8_BAR; }
    }
    PG8_WAIT_V(0);
    if constexpr (!ALIGN_EPI) { if (wr == 0) PG8_BAR; }
    PG8_BAR;
    if constexpr (Epi::AFTER_DRAIN) { E.fused(acc, cur, wr, wc, fr, fq, lds, wid, lane); S.done(cur); }
#undef PG8_SA
#undef PG8_SB
#undef PG8_STAGE
#undef PG8_LDA
#undef PG8_LDB
#undef PG8_MMA
#undef PG8_WAIT_V
#undef PG8_WAIT_L
#undef PG8_BAR
#undef PG8_SCHED
}
}

#define LAS __attribute__((address_space(3)))
#define XB_TMO      128
#define XB_XCNT(j)  (256  + 64 * (j))
#define XB_XSUB(j)  (1280 + 64 * (j))
#define XB_XGEN(j)  (2304 + 64 * (j))
#define XB_TOP      3328
#define XB_TOPGEN   3392
#define XCD_BAR_WORDS 3456
#define XB_SPIN_CAP (1u << 18)

__device__ __forceinline__ unsigned xb_ld(unsigned* p)              { return __hip_atomic_load(p, __ATOMIC_RELAXED, __HIP_MEMORY_SCOPE_AGENT); }
__device__ __forceinline__ unsigned xb_add(unsigned* p, unsigned v) { return __hip_atomic_fetch_add(p, v, __ATOMIC_RELAXED, __HIP_MEMORY_SCOPE_AGENT); }
__device__ __forceinline__ unsigned xb_xcc_id() { return (unsigned)__builtin_amdgcn_s_getreg((3 << 11) | 20) & 0xFu; }
#define XB_SPIN(cond, bar) do { unsigned _sp = 0; while (cond) { __builtin_amdgcn_s_sleep(1); \
    if ((++_sp & 255u) == 0u) { if (xb_ld(&(bar)[XB_TMO])) break; if (_sp > XB_SPIN_CAP) { atomicAdd(&(bar)[XB_TMO], 1u); break; } } } } while (0)

struct XcdBarrier {
    unsigned* bar; unsigned x;
    volatile LAS unsigned* st;
};

__device__ __forceinline__ XcdBarrier xcd_barrier_post(unsigned* bar, volatile LAS unsigned* st) {
    XcdBarrier b; b.bar = bar; b.x = xb_xcc_id(); b.st = st;
    if (threadIdx.x == 0) (void)xb_add(&bar[XB_XCNT(b.x)], 1u);
    return b;
}
__device__ __forceinline__ void xcd_barrier_complete(unsigned* bar, unsigned x, unsigned& nloc, unsigned& nx) {
    const unsigned G = gridDim.x * gridDim.y * gridDim.z;
    unsigned sum, cnt, mine, sp = 0u;
    for (;;) {
        sum = 0u; cnt = 0u; mine = 0u;
#pragma unroll
        for (unsigned j = 0; j < 16; ++j) { const unsigned c = xb_ld(&bar[XB_XCNT(j)]); sum += c; cnt += (c > 0u) ? 1u : 0u; mine = (j == x) ? c : mine; }
        if (sum == G) break;
        __builtin_amdgcn_s_sleep(1);
        if ((++sp & 255u) == 0u) { if (xb_ld(&bar[XB_TMO])) break; if (sp > XB_SPIN_CAP) { atomicAdd(&bar[XB_TMO], 1u); break; } }
    }
    nloc = mine > 0u ? mine : 1u; nx = cnt > 0u ? cnt : 1u;
}

__device__ __forceinline__ void xcd_barrier_protocol(const XcdBarrier& b) {
    {
        unsigned* bar = b.bar;
        __builtin_amdgcn_s_waitcnt(0);
        unsigned nloc = b.st[0], nx = b.st[1];
        if (nloc == 0u) { xcd_barrier_complete(bar, b.x, nloc, nx); b.st[0] = nloc; b.st[1] = nx; }
        const unsigned old = xb_add(&bar[XB_XSUB(b.x)], 1u);
        const unsigned gen = old / nloc;
        if (old + 1u == (gen + 1u) * nloc) {
            __builtin_amdgcn_fence(__ATOMIC_RELEASE, "agent");
            asm volatile("s_waitcnt vmcnt(0)" ::: "memory");
            const unsigned og = xb_add(&bar[XB_TOP], 1u);
            const unsigned tg = og / nx;
            if (og + 1u == (tg + 1u) * nx) xb_add(&bar[XB_TOPGEN], 1u);
            else XB_SPIN(xb_ld(&bar[XB_TOPGEN]) == tg, bar);
            __builtin_amdgcn_fence(__ATOMIC_ACQUIRE, "agent");
            xb_add(&bar[XB_XGEN(b.x)], 1u);
            asm volatile("s_waitcnt vmcnt(0)" ::: "memory");
        } else {
            XB_SPIN(xb_ld(&bar[XB_XGEN(b.x)]) == gen, bar);
            __builtin_amdgcn_fence(__ATOMIC_ACQUIRE, "agent");
            asm volatile("s_waitcnt vmcnt(0)" ::: "memory");
        }
    }
}
__device__ __forceinline__ void xcd_barrier(const XcdBarrier& b) {
    asm volatile("s_waitcnt vmcnt(0)" ::: "memory");
    __syncthreads();
    if (threadIdx.x == 0) xcd_barrier_protocol(b);
    __syncthreads();
}

typedef unsigned short bf16_t;
typedef short bf16x8 __attribute__((ext_vector_type(8)));
typedef short s16x4 __attribute__((ext_vector_type(4)));
typedef float f32x4 __attribute__((ext_vector_type(4)));
typedef float f32x16 __attribute__((ext_vector_type(16)));
typedef unsigned u32x4 __attribute__((ext_vector_type(4)));
typedef unsigned u32x2 __attribute__((ext_vector_type(2)));

constexpr int DM = 1024, SEQ = 16384, NSMP = 128, MP = 16640  , NZ = 2304;
constexpr int ZQ = 0, ZK = 512, ZV = 640, ZGA = 768, ZU = 1280, ZGP = 1792;
constexpr float EPS = 1e-6f, LOG2E = 1.4426950408889634f;
constexpr int LDS_CTL = 139264, LDS_BYTES = LDS_CTL + 64;
constexpr size_t WS_XB = 0;
constexpr size_t WS_RSTD = WS_XB + (size_t)MP * DM * 2;
constexpr size_t WS_WINT = WS_RSTD + (size_t)MP * 4;
constexpr size_t WS_WOUTT = WS_WINT + (size_t)NZ * DM * 2;
constexpr size_t WS_WPT = WS_WOUTT + (size_t)DM * DM * 2;
constexpr size_t WS_Z = WS_WPT + (size_t)4 * 128 * 128 * 2;
constexpr size_t WS_VT = WS_Z + (size_t)MP * NZ * 2;
constexpr size_t WS_MIX = WS_VT + (size_t)128 * MP * 2;
constexpr size_t WS_BAR = WS_MIX + (size_t)MP * DM * 2;
constexpr int BAR_WORDS = XCD_BAR_WORDS + 64 * 17;
constexpr size_t WS_END = WS_BAR + (size_t)BAR_WORDS * 4;
constexpr size_t O_YP = 0, O_YS = O_YP + (size_t)SEQ * DM, O_KP = O_YS + (size_t)NSMP * DM, O_VP = O_KP + 128 * 128, O_PP = O_VP + 128 * 128,
                 O_KS = O_PP + 15 * 512, O_VS = O_KS + (size_t)NSMP * 128 * 128, O_PS = O_VS + (size_t)NSMP * 128 * 128, O_END = O_PS + (size_t)NSMP * 15 * 512;

struct Args {
    const float *xp, *xs, *ck, *cv, *sp, *normw, *win, *qnw, *knw, *sinks, *wpool, *pscale, *wout;
    float* out; unsigned char* ws;
};

__device__ __forceinline__ float bf2f(unsigned b) { return __uint_as_float(b << 16); }
__device__ __forceinline__ unsigned pk2(float lo, float hi) { unsigned r; asm volatile("v_cvt_pk_bf16_f32 %0, %1, %2" : "=v"(r) : "v"(lo), "v"(hi)); return r; }
__device__ __forceinline__ float wave_sum(float v) {
#pragma unroll
    for (int o = 32; o > 0; o >>= 1) v += __shfl_xor(v, o);
    return v;
}
__device__ __forceinline__ float wave_max(float v) {
#pragma unroll
    for (int o = 32; o > 0; o >>= 1) v = fmaxf(v, __shfl_xor(v, o));
    return v;
}
__device__ __forceinline__ float silu(float x) { return x * __builtin_amdgcn_rcpf(1.0f + __expf(-x)); }
__device__ __forceinline__ void unpack8(const u32x4 w, float (&f)[8]) {
    f[0] = __uint_as_float(w.x << 16); f[1] = __uint_as_float(w.x & 0xffff0000u); f[2] = __uint_as_float(w.y << 16); f[3] = __uint_as_float(w.y & 0xffff0000u);
    f[4] = __uint_as_float(w.z << 16); f[5] = __uint_as_float(w.z & 0xffff0000u); f[6] = __uint_as_float(w.w << 16); f[7] = __uint_as_float(w.w & 0xffff0000u);
}

struct TileDesc { const float* src; bf16_t* dst; const float* kscale; const float* nscale; int K, N, k0, n0; };
__device__ __forceinline__ TileDesc tile_desc(const Args& a, int it) {
    constexpr int I_IN = 16 * 36, I_OUT = 16 * 16;
    TileDesc t;
    if (it < I_IN) { t.src = a.win; t.dst = (bf16_t*)(a.ws + WS_WINT); t.kscale = a.normw; t.nscale = nullptr; t.K = DM; t.N = NZ; t.k0 = (it & 15) * 64; t.n0 = (it >> 4) * 64; return t; }
    it -= I_IN;
    if (it < I_OUT) { t.src = a.wout; t.dst = (bf16_t*)(a.ws + WS_WOUTT); t.kscale = nullptr; t.nscale = nullptr; t.K = DM; t.N = DM; t.k0 = (it & 15) * 64; t.n0 = (it >> 4) * 64; return t; }
    it -= I_OUT;
    { const int g = it >> 2; t.src = a.wpool + g * 16384; t.dst = (bf16_t*)(a.ws + WS_WPT) + g * 16384; t.kscale = nullptr; t.nscale = a.pscale + g * 128; t.K = 128; t.N = 128; t.k0 = ((it >> 1) & 1) * 64; t.n0 = (it & 1) * 64; }
    return t;
}
__device__ __forceinline__ void p0_prologue(const Args& a, LAS unsigned char* lds) {
    int tid_ = threadIdx.x; asm volatile("" : "+v"(tid_)); const int tid = tid_, lane = tid & 63, wave = tid >> 6;
    bf16_t* XB = (bf16_t*)(a.ws + WS_XB);
    constexpr int NITEMS = 16 * 36 + 16 * 16 + 16;
    LAS float* scr = (LAS float*)lds;
    for (int it0 = blockIdx.x; it0 < NITEMS; it0 += 4 * gridDim.x) {
        f32x4 va[4], vb[4];
#pragma unroll
        for (int j = 0; j < 4; ++j) { const int it = it0 + j * gridDim.x;
            if (it < NITEMS) { const TileDesc t = tile_desc(a, it); const int kr = tid >> 3, c = tid & 7; const float* s = t.src + (size_t)(t.k0 + kr) * t.N + t.n0 + c * 8;
                va[j] = __builtin_nontemporal_load((const f32x4*)s); vb[j] = __builtin_nontemporal_load((const f32x4*)(s + 4));
                const float sc = t.kscale ? t.kscale[t.k0 + kr] : 1.0f; va[j] *= sc; vb[j] *= sc;
                if (t.nscale) { va[j] *= *(const f32x4*)(t.nscale + t.n0 + c * 8); vb[j] *= *(const f32x4*)(t.nscale + t.n0 + c * 8 + 4); } } }
#pragma unroll
        for (int j = 0; j < 4; ++j) { const int it = it0 + j * gridDim.x;
            if (it < NITEMS) { const TileDesc t = tile_desc(a, it);
                { const int kr = tid >> 3, c = tid & 7; LAS float* d = scr + kr * 65 + c * 8;
                  d[0] = va[j].x; d[1] = va[j].y; d[2] = va[j].z; d[3] = va[j].w; d[4] = vb[j].x; d[5] = vb[j].y; d[6] = vb[j].z; d[7] = vb[j].w; }
                __syncthreads();
                { const int n = tid >> 3, kc = tid & 7; const LAS float* sp = scr + (kc * 8) * 65 + n;
                  u32x4 o; o.x = pk2(sp[0], sp[65]); o.y = pk2(sp[130], sp[195]); o.z = pk2(sp[260], sp[325]); o.w = pk2(sp[390], sp[455]);
                  *(u32x4*)(t.dst + (size_t)(t.n0 + n) * t.K + t.k0 + kc * 8) = o; }
                __syncthreads(); } }
    }
    const int gw = blockIdx.x * 8 + wave, NGW = gridDim.x * 8;
    for (int m0 = gw; m0 < MP; m0 += 2 * NGW) {
        f32x4 v[2][4];
#pragma unroll
        for (int q = 0; q < 2; ++q) { const int m = m0 + q * NGW;
            if (m < SEQ + NSMP) { const float* xr = (m < SEQ) ? a.xp + (size_t)m * DM : a.xs + (size_t)(m - SEQ) * DM; const f32x4* x4 = (const f32x4*)xr + lane;
#pragma unroll
                for (int j = 0; j < 4; ++j) v[q][j] = __builtin_nontemporal_load(x4 + 64 * j); }
            else {
#pragma unroll
                for (int j = 0; j < 4; ++j) v[q][j] = (f32x4){0.f, 0.f, 0.f, 0.f}; } }
#pragma unroll
        for (int q = 0; q < 2; ++q) { const int m = m0 + q * NGW;
            if (m < MP) { float ss = 0.f;
#pragma unroll
                for (int j = 0; j < 4; ++j) ss += (v[q][j].x * v[q][j].x + v[q][j].y * v[q][j].y) + (v[q][j].z * v[q][j].z + v[q][j].w * v[q][j].w);
                ss = wave_sum(ss);
                const float rs = 1.0f / sqrtf(ss * (1.0f / DM) + EPS);
                unsigned long long* o8 = (unsigned long long*)(XB + (size_t)m * DM) + lane;
#pragma unroll
                for (int j = 0; j < 4; ++j) o8[64 * j] = (unsigned long long)pk2(v[q][j].x * rs, v[q][j].y * rs) | ((unsigned long long)pk2(v[q][j].z * rs, v[q][j].w * rs) << 32); } }
    }
}

constexpr int KS_STRIDE = 144, VS_STRIDE = 520, KS_OFF = 0, VS_OFF = 256 * KS_STRIDE;

__device__ __forceinline__ void attn_item(const Args& a, LAS unsigned char* lds, int qb, int kvh, int hsel) {
    int tid_ = threadIdx.x; asm volatile("" : "+v"(tid_)); const int tid = tid_, lane = tid & 63, wave = __builtin_amdgcn_readfirstlane(tid >> 6);
    const bf16_t* __restrict__ Z = (const bf16_t*)(a.ws + WS_Z); const bf16_t* __restrict__ VT = (const bf16_t*)(a.ws + WS_VT); bf16_t* __restrict__ MIX = (bf16_t*)(a.ws + WS_MIX);
    const int key_base = (qb - 1) * 128;
    const int head = kvh * 4 + ((hsel == 2) ? (wave >> 1) : (2 * hsel + (wave >> 2))), sb0 = (hsel == 2) ? 2 * (wave & 1) : (wave & 3), nsb = (hsel == 2) ? 2 : 1, r = lane & 31, h = lane >> 5;
    u32x4 kw[4], vw[4], qw[4];
#pragma unroll
    for (int i = 0; i < 4; ++i) { const int task = tid + 512 * i, kk = task >> 3, c = task & 7, pos = max(key_base + kk, 0);
        kw[i] = *(const u32x4*)(Z + (size_t)pos * NZ + ZK + kvh * 64 + c * 8); }
#pragma unroll
    for (int i = 0; i < 4; ++i) { const int task = tid + 512 * i, d = task >> 5, c = task & 31, pos = max(key_base + c * 8, 0);
        vw[i] = *(const u32x4*)(VT + (size_t)(kvh * 64 + d) * MP + pos); }
#pragma unroll
    for (int s = 0; s < 4; ++s) qw[s] = *(const u32x4*)(Z + (size_t)(qb * 128 + 32 * sb0 + r) * NZ + ZQ + head * 64 + 16 * s + 8 * h);
    u32x2 pvw[4];
    if (qb == 127) {
#pragma unroll
        for (int i = 0; i < 4; ++i) { const int idx = tid + 512 * i, t = idx >> 4, c4 = idx & 15; pvw[i] = *(const u32x2*)(Z + (size_t)(SEQ - 128 + t) * NZ + ZV + kvh * 64 + c4 * 4); }
    }
#pragma unroll
    for (int i = 0; i < 4; ++i) {
        const int task = tid + 512 * i, kk = task >> 3, c = task & 7;
        float f[8];
        u32x4 w = kw[i];
        if (key_base + kk < 0) w = (u32x4){0u, 0u, 0u, 0u};
        unpack8(w, f);
        float ss = 0.f;
#pragma unroll
        for (int j = 0; j < 8; ++j) ss += f[j] * f[j];
        ss += __shfl_xor(ss, 1); ss += __shfl_xor(ss, 2); ss += __shfl_xor(ss, 4);
        const float rr = 1.0f / sqrtf(ss * (1.0f / 64.0f) + EPS);
#pragma unroll
        for (int j = 0; j < 8; ++j) f[j] *= rr;
        if (qb == 127 && kk >= 128) {
            const f32x4 kn0 = *(const f32x4*)(a.knw + c * 8), kn1 = *(const f32x4*)(a.knw + c * 8 + 4);
            float* o = a.out + O_KP + (size_t)((kk - 128) * 2 + kvh) * 64 + c * 8;
            *(f32x4*)o = (f32x4){f[0] * kn0.x, f[1] * kn0.y, f[2] * kn0.z, f[3] * kn0.w}; *(f32x4*)(o + 4) = (f32x4){f[4] * kn1.x, f[5] * kn1.y, f[6] * kn1.z, f[7] * kn1.w};
        }
        u32x4 o; o.x = pk2(f[0], f[1]); o.y = pk2(f[2], f[3]); o.z = pk2(f[4], f[5]); o.w = pk2(f[6], f[7]);
        *(LAS u32x4*)(lds + KS_OFF + kk * KS_STRIDE + c * 16) = o;
    }
#pragma unroll
    for (int i = 0; i < 4; ++i) {
        const int task = tid + 512 * i, d = task >> 5, c = task & 31;
        u32x4 w = vw[i];
        if (key_base + c * 8 < 0) w = (u32x4){0u, 0u, 0u, 0u};
        LAS u32x2* p = (LAS u32x2*)(lds + VS_OFF + d * VS_STRIDE + c * 16);
        p[0] = (u32x2){w.x, w.y}; p[1] = (u32x2){w.z, w.w};
    }
    if (qb == 127) {
#pragma unroll
        for (int i = 0; i < 4; ++i) { const int idx = tid + 512 * i, t = idx >> 4, c4 = idx & 15; const u32x2 w = pvw[i];
            *(f32x4*)(a.out + O_VP + (size_t)(t * 2 + kvh) * 64 + c4 * 4) = (f32x4){__uint_as_float(w.x << 16), __uint_as_float(w.x & 0xffff0000u), __uint_as_float(w.y << 16), __uint_as_float(w.y & 0xffff0000u)}; }
    }
    if (tid < 64) ((LAS float*)(lds + VS_OFF + 64 * VS_STRIDE))[tid] = a.qnw[tid] * a.knw[tid];
    __syncthreads();
    const float sink2 = a.sinks[head] * LOG2E;
#pragma unroll 1
    for (int sb = sb0; sb < sb0 + nsb; ++sb) {
        const int qs = qb * 128 + 32 * sb, row = qs + r;
        u32x4 qn[4];
        if (sb + 1 < sb0 + nsb) {
#pragma unroll
            for (int s = 0; s < 4; ++s) qn[s] = *(const u32x4*)(Z + (size_t)(qb * 128 + 32 * (sb + 1) + r) * NZ + ZQ + head * 64 + 16 * s + 8 * h);
        } else {
#pragma unroll
            for (int s = 0; s < 4; ++s) qn[s] = (u32x4){0u, 0u, 0u, 0u};
        }
        u32x4 gq[2][2];
#pragma unroll
        for (int dt = 0; dt < 2; ++dt)
#pragma unroll
            for (int kp = 0; kp < 2; ++kp) gq[dt][kp] = *(const u32x4*)(Z + (size_t)row * NZ + ZGA + head * 64 + dt * 32 + 16 * kp + 8 * h);
        bf16x8 qf[4];
        { float f[4][8]; float ss = 0.f;
#pragma unroll
          for (int s = 0; s < 4; ++s) { unpack8(qw[s], f[s]);
#pragma unroll
              for (int j = 0; j < 8; ++j) ss += f[s][j] * f[s][j]; }
          ss += __shfl_xor(ss, 32);
          const float rq = (1.0f / sqrtf(ss * (1.0f / 64.0f) + EPS)) * (0.125f * LOG2E);
#pragma unroll
          for (int s = 0; s < 4; ++s) { const f32x4 n0 = *(const LAS f32x4*)(lds + VS_OFF + 64 * VS_STRIDE + (16 * s + 8 * h) * 4), n1 = *(const LAS f32x4*)(lds + VS_OFF + 64 * VS_STRIDE + (16 * s + 8 * h + 4) * 4);
              u32x4 o; o.x = pk2(f[s][0] * rq * n0.x, f[s][1] * rq * n0.y); o.y = pk2(f[s][2] * rq * n0.z, f[s][3] * rq * n0.w);
              o.z = pk2(f[s][4] * rq * n1.x, f[s][5] * rq * n1.y); o.w = pk2(f[s][6] * rq * n1.z, f[s][7] * rq * n1.w);
              qf[s] = __builtin_bit_cast(bf16x8, o); } }
        const int kt0 = sb;
        f32x16 S[5];
        bf16x8 kf[2][4];
#pragma unroll
        for (int s = 0; s < 4; ++s) kf[0][s] = *(const LAS bf16x8*)(lds + KS_OFF + (kt0 * 32 + r) * KS_STRIDE + (16 * s + 8 * h) * 2);
#pragma unroll
        for (int i = 0; i < 5; ++i) {
            if (i + 1 < 5) {
#pragma unroll
                for (int s = 0; s < 4; ++s) kf[(i + 1) & 1][s] = *(const LAS bf16x8*)(lds + KS_OFF + ((kt0 + i + 1) * 32 + r) * KS_STRIDE + (16 * s + 8 * h) * 2);
            }
            const float s_init = (qb == 0 && kt0 + i < 4) ? -1e30f : 0.f;
#pragma unroll
            for (int e = 0; e < 16; ++e) S[i][e] = s_init;
            __builtin_amdgcn_sched_barrier(0);
#pragma unroll
            for (int s = 0; s < 4; ++s) S[i] = __builtin_amdgcn_mfma_f32_32x32x16_bf16(kf[i & 1][s], qf[s], S[i], 0, 0, 0);
            __builtin_amdgcn_sched_barrier(0);
        }
#pragma unroll
        for (int e = 0; e < 16; ++e) { const int rk = (e & 3) + 8 * (e >> 2) + 4 * h;
            S[0][e] = (rk >= r) ? S[0][e] : -1e30f; S[4][e] = (rk <= r) ? S[4][e] : -1e30f; }
        float mx = sink2;
#pragma unroll
        for (int i = 0; i < 5; ++i)
#pragma unroll
            for (int e = 0; e < 16; ++e) mx = fmaxf(mx, S[i][e]);
        mx = fmaxf(mx, __shfl_xor(mx, 32));
        float l = 0.f;
#pragma unroll
        for (int i = 0; i < 5; ++i)
#pragma unroll
            for (int e = 0; e < 16; ++e) { const float p = __builtin_amdgcn_exp2f(S[i][e] - mx); S[i][e] = p; l += p; }
        l += __shfl_xor(l, 32);
        l += __builtin_amdgcn_exp2f(sink2 - mx);
        f32x16 O[2];
#pragma unroll
        for (int dt = 0; dt < 2; ++dt)
#pragma unroll
            for (int e = 0; e < 16; ++e) O[dt][e] = 0.f;
        bf16x8 vfr[4][2];
#define ATT_VREAD(T, DT) do { const LAS unsigned char* vp_ = lds + VS_OFF + ((DT) * 32 + r) * VS_STRIDE + ((kt0 + ((T) >> 1)) * 32 + 16 * ((T) & 1) + 4 * h) * 2; \
            const s16x4 v0_ = *(const LAS s16x4*)vp_, v1_ = *(const LAS s16x4*)(vp_ + 16); vfr[(T) & 3][DT] = __builtin_shufflevector(v0_, v1_, 0, 1, 2, 3, 4, 5, 6, 7); } while (0)
#pragma unroll
        for (int t = 0; t < 3; ++t) { ATT_VREAD(t, 0); ATT_VREAD(t, 1); }
#pragma unroll
        for (int t = 0; t < 10; ++t) {
            const int i = t >> 1, s2 = t & 1;
            if (t + 3 < 10) { ATT_VREAD(t + 3, 0); ATT_VREAD(t + 3, 1); }
            u32x4 pw; pw.x = pk2(S[i][8 * s2 + 0], S[i][8 * s2 + 1]); pw.y = pk2(S[i][8 * s2 + 2], S[i][8 * s2 + 3]);
            pw.z = pk2(S[i][8 * s2 + 4], S[i][8 * s2 + 5]); pw.w = pk2(S[i][8 * s2 + 6], S[i][8 * s2 + 7]);
            const bf16x8 pf = __builtin_bit_cast(bf16x8, pw);
            __builtin_amdgcn_sched_barrier(0);
            O[0] = __builtin_amdgcn_mfma_f32_32x32x16_bf16(vfr[t & 3][0], pf, O[0], 0, 0, 0);
            O[1] = __builtin_amdgcn_mfma_f32_32x32x16_bf16(vfr[t & 3][1], pf, O[1], 0, 0, 0);
            __builtin_amdgcn_sched_barrier(0);
        }
#undef ATT_VREAD
        const float inv = 1.0f / l;
#pragma unroll
        for (int dt = 0; dt < 2; ++dt)
#pragma unroll
            for (int kp = 0; kp < 2; ++kp) {
                u32x2 X = (u32x2){gq[dt][kp].x, gq[dt][kp].y}, Y = (u32x2){gq[dt][kp].z, gq[dt][kp].w};
                { auto r0 = __builtin_amdgcn_permlane32_swap(X.x, Y.x, false, false); X.x = r0[0]; Y.x = r0[1];
                  auto r1 = __builtin_amdgcn_permlane32_swap(X.y, Y.y, false, false); X.y = r1[0]; Y.y = r1[1]; }
                u32x2 o[2];
#pragma unroll
                for (int q = 0; q < 2; ++q) { const int g4 = 2 * kp + q; const u32x2 g = q ? Y : X;
                    const float g0 = __uint_as_float(g.x << 16), g1 = __uint_as_float(g.x & 0xffff0000u), g2 = __uint_as_float(g.y << 16), g3 = __uint_as_float(g.y & 0xffff0000u);
                    o[q].x = pk2(O[dt][4 * g4 + 0] * inv * g0, O[dt][4 * g4 + 1] * inv * g1);
                    o[q].y = pk2(O[dt][4 * g4 + 2] * inv * g2, O[dt][4 * g4 + 3] * inv * g3); }
                { auto r0 = __builtin_amdgcn_permlane32_swap(o[0].x, o[1].x, false, false); o[0].x = r0[0]; o[1].x = r0[1];
                  auto r1 = __builtin_amdgcn_permlane32_swap(o[0].y, o[1].y, false, false); o[0].y = r1[0]; o[1].y = r1[1]; }
                *(u32x4*)(MIX + (size_t)row * DM + head * 64 + dt * 32 + 16 * kp + 8 * h) = (u32x4){o[0].x, o[0].y, o[1].x, o[1].y};
            }
#pragma unroll
        for (int s = 0; s < 4; ++s) qw[s] = qn[s];
    }
    __syncthreads();
}

constexpr int PD_OFF = 0, PD_STRIDE = 528, PW_OFF = 128 * 528, PW_STRIDE = 272;
template <int WLEN>
__device__ __forceinline__ void window_pass(const u32x4 (&u)[23], LAS unsigned char* dst  , int tok0  ) {
    float s[8];
#pragma unroll
    for (int c = 0; c < 8; ++c) s[c] = 0.f;
#pragma unroll
    for (int j = 1; j < WLEN; ++j) { float f[8]; unpack8(u[15 - j], f);
#pragma unroll
        for (int c = 0; c < 8; ++c) s[c] += f[c]; }
#pragma unroll
    for (int tl = 0; tl < 8; ++tl) {
        float f[8], fo[8]; unpack8(u[15 + tl], f); unpack8(u[15 + tl - WLEN + 1], fo);
        const int cnt = min(WLEN, tok0 + tl + 1); const float ic = (cnt == WLEN) ? (1.0f / WLEN) : 1.0f / (float)cnt;
        float d[8];
#pragma unroll
        for (int c = 0; c < 8; ++c) { s[c] += f[c]; d[c] = s[c] * ic - f[c]; s[c] -= fo[c]; }
        u32x4 o; o.x = pk2(d[0], d[1]); o.y = pk2(d[2], d[3]); o.z = pk2(d[4], d[5]); o.w = pk2(d[6], d[7]);
        *(LAS u32x4*)(dst + tl * PD_STRIDE) = o;
    }
}
struct PoolRegs { u32x4 u[23]; u32x4 gq[2][2][2]; };
__device__ __forceinline__ void pool_load(const Args& a, int tile, int gp, PoolRegs& R) {
    int tid_ = threadIdx.x; asm volatile("" : "+v"(tid_)); const int tid = tid_, lane = tid & 63, wave = __builtin_amdgcn_readfirstlane(tid >> 6), fr = lane & 15, fq = lane >> 4;
    const bf16_t* __restrict__ Z = (const bf16_t*)(a.ws + WS_Z);
    const int t0 = tile * 128, gl = wave & 1, g = gp * 2 + gl, tb = (wave >> 1) * 32;
#pragma unroll
    for (int j = 0; j < 23; ++j) { const int pos = max(t0 + tb + 8 * (lane >> 4) - 15 + j, 0); R.u[j] = *(const u32x4*)(Z + (size_t)pos * NZ + ZU + g * 128 + (lane & 15) * 8); }
#pragma unroll
    for (int q = 0; q < 2; ++q)
#pragma unroll
        for (int m = 0; m < 2; ++m)
#pragma unroll
            for (int np = 0; np < 2; ++np) R.gq[q][m][np] = *(const u32x4*)(Z + (size_t)(t0 + tb + 16 * m + fr) * NZ + ZGP + (gp * 2 + q) * 128 + 64 * (wave & 1) + 16 * (2 * np + (fq & 1)) + 8 * (fq >> 1));
}
__device__ __forceinline__ void pool_item(const Args& a, LAS unsigned char* lds, int tile, int gp, PoolRegs& R) {
    int tid_ = threadIdx.x; asm volatile("" : "+v"(tid_)); const int tid = tid_, lane = tid & 63, wave = __builtin_amdgcn_readfirstlane(tid >> 6), fr = lane & 15, fq = lane >> 4;
    const bf16_t* __restrict__ WPT = (const bf16_t*)(a.ws + WS_WPT); bf16_t* __restrict__ MIX = (bf16_t*)(a.ws + WS_MIX);
    const int t0 = tile * 128;
    u32x4 ww[8];
#pragma unroll
    for (int i = 0; i < 8; ++i) { const int task = tid + 512 * i, rr = task >> 4, c = task & 15; ww[i] = *(const u32x4*)(WPT + (size_t)(gp * 2) * 16384 + rr * 128 + c * 8); }
    const int gl = wave & 1, g = gp * 2 + gl, tb = (wave >> 1) * 32;
    u32x4 (&u)[23] = R.u;
    const int sub = lane >> 4;
    if (tile == 0) {
#pragma unroll
        for (int j = 0; j < 15; ++j) if (tb + 8 * sub - 15 + j < 0) u[j] = (u32x4){0u, 0u, 0u, 0u};
    }
    const int row = t0 + wave * 16 + fr;
#pragma unroll
    for (int i = 0; i < 8; ++i) { const int task = tid + 512 * i, rr = task >> 4, c = task & 15; *(LAS u32x4*)(lds + PW_OFF + rr * PW_STRIDE + c * 16) = ww[i]; }
    { LAS unsigned char* dst = lds + PD_OFF + (tb + 8 * sub) * PD_STRIDE + gl * 256 + (lane & 15) * 16; const int tok0 = (tile == 0) ? tb + 8 * sub : 1000000;
      if (g == 0) window_pass<2>(u, dst, tok0); else if (g == 1) window_pass<4>(u, dst, tok0); else if (g == 2) window_pass<8>(u, dst, tok0); else window_pass<16>(u, dst, tok0); }
    if (tile == 127 && tb == 96 && sub >= 2) {
#pragma unroll
        for (int tl = 0; tl < 8; ++tl) { const int i = 96 + 8 * sub + tl - 113;
            if (i >= 0) { float f[8]; unpack8(u[15 + tl], f); float* o = a.out + O_PP + (size_t)i * 512 + g * 128 + (lane & 15) * 8;
                *(f32x4*)o = (f32x4){f[0], f[1], f[2], f[3]}; *(f32x4*)(o + 4) = (f32x4){f[4], f[5], f[6], f[7]}; } }
    }
    __syncthreads();
    f32x4 acc[2][8];
#pragma unroll
    for (int q = 0; q < 2; ++q)
#pragma unroll
        for (int n = 0; n < 8; ++n) acc[q][n] = (f32x4){0.f, 0.f, 0.f, 0.f};
    const int ddh = wave & 1;
    bf16x8 fa[2][2], fb[2][4];
#define POOL_FRAGS(T) do { const int q_ = (T) >> 2, kk_ = (T) & 3; \
        _Pragma("unroll") for (int m = 0; m < 2; ++m) fa[(T) & 1][m] = *(const LAS bf16x8*)(lds + PD_OFF + (tb + 16 * m + fr) * PD_STRIDE + q_ * 256 + (32 * kk_ + 8 * fq) * 2); \
        _Pragma("unroll") for (int n = 0; n < 4; ++n) fb[(T) & 1][n] = *(const LAS bf16x8*)(lds + PW_OFF + (q_ * 128 + 64 * ddh + 16 * n + fr) * PW_STRIDE + (32 * kk_ + 8 * fq) * 2); } while (0)
    POOL_FRAGS(0);
#pragma unroll
    for (int t = 0; t < 8; ++t) {
        if (t + 1 < 8) POOL_FRAGS(t + 1);
        __builtin_amdgcn_sched_barrier(0);
#pragma unroll
        for (int n = 0; n < 4; ++n)
#pragma unroll
            for (int m = 0; m < 2; ++m) acc[t >> 2][4 * m + n] = __builtin_amdgcn_mfma_f32_16x16x32_bf16(fb[t & 1][n], fa[t & 1][m], acc[t >> 2][4 * m + n], 0, 0, 0);
        __builtin_amdgcn_sched_barrier(0);
    }
#undef POOL_FRAGS
#pragma unroll
    for (int q = 0; q < 2; ++q)
#pragma unroll
        for (int m = 0; m < 2; ++m)
#pragma unroll
            for (int np = 0; np < 2; ++np) {
                const u32x4 gq = R.gq[q][m][np];
                u32x2 X = (u32x2){gq.x, gq.y}, Y = (u32x2){gq.z, gq.w};
                { auto r0 = __builtin_amdgcn_permlane16_swap(X.x, Y.x, false, false); X.x = r0[0]; Y.x = r0[1];
                  auto r1 = __builtin_amdgcn_permlane16_swap(X.y, Y.y, false, false); X.y = r1[0]; Y.y = r1[1]; }
                u32x2 o[2];
#pragma unroll
                for (int e = 0; e < 2; ++e) { const u32x2 gv = e ? Y : X; const f32x4 y = acc[q][4 * m + 2 * np + e];
                    const float g0 = __uint_as_float(gv.x << 16), g1 = __uint_as_float(gv.x & 0xffff0000u), g2 = __uint_as_float(gv.y << 16), g3 = __uint_as_float(gv.y & 0xffff0000u);
                    o[e].x = pk2(y.x * g0, y.y * g1); o[e].y = pk2(y.z * g2, y.w * g3); }
                { auto r0 = __builtin_amdgcn_permlane16_swap(o[0].x, o[1].x, false, false); o[0].x = r0[0]; o[1].x = r0[1];
                  auto r1 = __builtin_amdgcn_permlane16_swap(o[0].y, o[1].y, false, false); o[0].y = r1[0]; o[1].y = r1[1]; }
                *(u32x4*)(MIX + (size_t)(t0 + tb + 16 * m + fr) * DM + 512 + (gp * 2 + q) * 128 + 64 * ddh + 16 * (2 * np + (fq & 1)) + 8 * (fq >> 1)) = (u32x4){o[0].x, o[0].y, o[1].x, o[1].y};
            }
    __syncthreads();
}

struct SampleRegs { f32x4 kv[4], vv[4]; float spv[15]; float un, newv; };
__device__ __forceinline__ void sample_load(const Args& a, int b, int half, SampleRegs& R) {
    int tid_ = threadIdx.x; asm volatile("" : "+v"(tid_)); const int tid = tid_, lane = tid & 63, wave = __builtin_amdgcn_readfirstlane(tid >> 6);
    const bf16_t* __restrict__ Z = (const bf16_t*)(a.ws + WS_Z); const bf16_t* zrow = Z + (size_t)(SEQ + b) * NZ; const int kvh = half;
#pragma unroll
    for (int i = 0; i < 4; ++i) { const int idx = tid + 512 * i, key = idx >> 4, c4 = idx & 15; const size_t src = ((size_t)(b * 128 + key) * 2 + kvh) * 64 + c4 * 4;
        R.kv[i] = __builtin_nontemporal_load((const f32x4*)(a.ck + src)); R.vv[i] = __builtin_nontemporal_load((const f32x4*)(a.cv + src)); }
    const int pt = tid & 255, pgl = pt >> 7, pc = pt & 127, pg = half * 2 + pgl, pch = pg * 128 + pc;
    R.un = 0.f;
#pragma unroll
    for (int i = 0; i < 15; ++i) R.spv[i] = 0.f;
    if (tid >= 256) {
#pragma unroll
        for (int i = 0; i < 15; ++i) R.spv[i] = __builtin_nontemporal_load(a.sp + ((size_t)b * 15 + i) * 512 + pch);
        R.un = bf2f(zrow[ZU + pch]);
    }
    R.newv = 0.f;
    if (wave == 0) R.newv = bf2f(zrow[ZK + kvh * 64 + lane]); else if (wave == 1) R.newv = bf2f(zrow[ZV + kvh * 64 + lane]); else if (wave < 6) R.newv = bf2f(zrow[ZQ + (kvh * 4 + wave - 2) * 64 + lane]);
}
__device__ __forceinline__ void sample_item(const Args& a, LAS unsigned char* lds, int b, int half, const SampleRegs& R) {
    int tid_ = threadIdx.x; asm volatile("" : "+v"(tid_)); const int tid = tid_, lane = tid & 63, wave = __builtin_amdgcn_readfirstlane(tid >> 6), fr = lane & 15, fq = lane >> 4;
    const bf16_t* __restrict__ Z = (const bf16_t*)(a.ws + WS_Z); const bf16_t* __restrict__ WPT = (const bf16_t*)(a.ws + WS_WPT); bf16_t* __restrict__ MIX = (bf16_t*)(a.ws + WS_MIX);
    const bf16_t* zrow = Z + (size_t)(SEQ + b) * NZ; bf16_t* mrow = MIX + (size_t)(SEQ + b) * DM;
    LAS float* Kc = (LAS float*)lds;
    LAS float* Vc = Kc + 129 * 65 + 3;
    LAS float* qs = Vc + 129 * 64;
    LAS bf16_t* dvb = (LAS bf16_t*)(qs + 256);
    const int kvh = half;
    const int pt = tid & 255, pgl = pt >> 7, pc = pt & 127, pg = half * 2 + pgl, pch = pg * 128 + pc;
    const f32x4 (&kv)[4] = R.kv; const f32x4 (&vv)[4] = R.vv; const float (&spv)[15] = R.spv; const float un = R.un, newv = R.newv;
    bf16x8 wfr[4][4];
    if (wave >= 4) {
#pragma unroll
        for (int t = 0; t < 4; ++t) { const int nt = (wave - 4) * 4 + t, q = nt >> 3, n = nt & 7;
#pragma unroll
            for (int kk = 0; kk < 4; ++kk) wfr[t][kk] = *(const bf16x8*)(WPT + (size_t)(half * 2 + q) * 16384 + (16 * n + fr) * 128 + 32 * kk + 8 * fq); }
    }
#pragma unroll
    for (int i = 0; i < 4; ++i) { const int idx = tid + 512 * i, key = idx >> 4, c4 = idx & 15;
        LAS float* kd = Kc + key * 65 + c4 * 4; kd[0] = kv[i].x; kd[1] = kv[i].y; kd[2] = kv[i].z; kd[3] = kv[i].w;
        *(LAS f32x4*)(Vc + key * 64 + c4 * 4) = vv[i];
        if (key >= 1) { const size_t dst = ((size_t)(b * 128 + key - 1) * 2 + kvh) * 64 + c4 * 4; __builtin_nontemporal_store(kv[i], (f32x4*)(a.out + O_KS + dst)); __builtin_nontemporal_store(vv[i], (f32x4*)(a.out + O_VS + dst)); } }
    if (wave == 0) { const float ss = wave_sum(newv * newv); const float kn = newv * (1.0f / sqrtf(ss * (1.0f / 64.0f) + EPS)) * a.knw[lane];
        Kc[128 * 65 + lane] = kn; a.out[O_KS + ((size_t)(b * 128 + 127) * 2 + kvh) * 64 + lane] = kn; }
    else if (wave == 1) { Vc[128 * 64 + lane] = newv; a.out[O_VS + ((size_t)(b * 128 + 127) * 2 + kvh) * 64 + lane] = newv; }
    else if (wave < 6) { const float ss = wave_sum(newv * newv); qs[(wave - 2) * 64 + lane] = newv * (1.0f / sqrtf(ss * (1.0f / 64.0f) + EPS)) * a.qnw[lane] * 0.125f; }
    if (tid >= 256) { const int wlen = 2 << pg; float s = un; float* po = a.out + O_PS + (size_t)b * 15 * 512 + pch;
#pragma unroll
        for (int i = 0; i < 15; ++i) { if (i >= 16 - wlen) s += spv[i]; if (i >= 1) __builtin_nontemporal_store(spv[i], po + (size_t)(i - 1) * 512); }
        po[(size_t)14 * 512] = un;
        dvb[pgl * 128 + pc] = (bf16_t)(pk2(s / (float)wlen - un, 0.f) & 0xffffu); }
    __syncthreads();
    if (wave < 4) { const int hl = wave; const float sink = a.sinks[kvh * 4 + hl];
        const int col = (kvh * 4 + hl) * 64 + lane; const float ga = bf2f(zrow[ZGA + col]);
        float s0 = 0.f, s1 = 0.f, s2 = 0.f;
#pragma unroll 16
        for (int d = 0; d < 64; ++d) { const float q = qs[hl * 64 + d]; s0 += q * Kc[lane * 65 + d]; s1 += q * Kc[(lane + 64) * 65 + d]; s2 += q * Kc[128 * 65 + d]; }
        const float m = fmaxf(fmaxf(wave_max(fmaxf(s0, s1)), s2), sink);
        const float p0 = __expf(s0 - m), p1 = __expf(s1 - m), p2 = __expf(s2 - m);
        const float inv = 1.0f / (wave_sum(p0 + p1) + p2 + __expf(sink - m));
        float o = p2 * Vc[128 * 64 + lane];
#pragma unroll
        for (int key = 0; key < 64; ++key) { o += __uint_as_float(__builtin_amdgcn_readlane(__float_as_uint(p0), key)) * Vc[key * 64 + lane]; o += __uint_as_float(__builtin_amdgcn_readlane(__float_as_uint(p1), key)) * Vc[(key + 64) * 64 + lane]; }
        mrow[col] = (bf16_t)(pk2(o * inv * ga, 0.f) & 0xffffu); }
    else {
        f32x4 acc[4];
#pragma unroll
        for (int t = 0; t < 4; ++t) acc[t] = (f32x4){0.f, 0.f, 0.f, 0.f};
#pragma unroll
        for (int t = 0; t < 4; ++t) { const int nt = (wave - 4) * 4 + t, q = nt >> 3;
#pragma unroll
            for (int kk = 0; kk < 4; ++kk) { bf16x8 af = *(const LAS bf16x8*)(dvb + q * 128 + 32 * kk + 8 * fq);
                if (fr != 0) af = (bf16x8){0, 0, 0, 0, 0, 0, 0, 0};
                acc[t] = __builtin_amdgcn_mfma_f32_16x16x32_bf16(wfr[t][kk], af, acc[t], 0, 0, 0); } }
        if (fr == 0) {
#pragma unroll
            for (int t = 0; t < 4; ++t) { const int nt = (wave - 4) * 4 + t, q = nt >> 3, n = nt & 7, col = (half * 2 + q) * 128 + 16 * n + 4 * fq;
                const u32x2 gv = *(const u32x2*)(zrow + ZGP + col);
                const float g0 = __uint_as_float(gv.x << 16), g1 = __uint_as_float(gv.x & 0xffff0000u), g2 = __uint_as_float(gv.y << 16), g3 = __uint_as_float(gv.y & 0xffff0000u);
                u32x2 o; o.x = pk2(acc[t].x * g0, acc[t].y * g1); o.y = pk2(acc[t].z * g2, acc[t].w * g3);
                *(u32x2*)(mrow + 512 + col) = o; } }
    }
    __syncthreads();
}

__device__ __forceinline__ void sample_out_piece(const Args& a, LAS unsigned char* lds, int piece) {
    int tid_ = threadIdx.x; asm volatile("" : "+v"(tid_)); const int tid = tid_, lane = tid & 63, wave = __builtin_amdgcn_readfirstlane(tid >> 6), fr = lane & 15, fq = lane >> 4;
    const bf16_t* MIX = (const bf16_t*)(a.ws + WS_MIX); const bf16_t* WOUTT = (const bf16_t*)(a.ws + WS_WOUTT);
    const int pr = piece >> 5, pc = piece & 31;
    f32x4 acc[2] = {(f32x4){0.f, 0.f, 0.f, 0.f}, (f32x4){0.f, 0.f, 0.f, 0.f}};
#pragma unroll
    for (int kk = 0; kk < 4; ++kk) { const int k = wave * 128 + kk * 32 + fq * 8;
        const bf16x8 af = *(const bf16x8*)(MIX + (size_t)(SEQ + pr * 16 + fr) * DM + k);
#pragma unroll
        for (int n = 0; n < 2; ++n) { const bf16x8 bfr = *(const bf16x8*)(WOUTT + (size_t)(pc * 32 + n * 16 + fr) * DM + k);
            acc[n] = __builtin_amdgcn_mfma_f32_16x16x32_bf16(bfr, af, acc[n], 0, 0, 0); } }
    LAS f32x4* red = (LAS f32x4*)lds;
    red[(wave * 2 + 0) * 64 + lane] = acc[0]; red[(wave * 2 + 1) * 64 + lane] = acc[1];
    __syncthreads();
    if (tid < 128) { const int n = tid >> 6; f32x4 s = (f32x4){0.f, 0.f, 0.f, 0.f};
#pragma unroll
        for (int w = 0; w < 8; ++w) s += red[(w * 2 + n) * 64 + lane];
        const size_t off = (size_t)(pr * 16 + fr) * DM + pc * 32 + n * 16 + 4 * fq;
        *(f32x4*)(a.out + O_YS + off) = *(const f32x4*)(a.xs + off) + s; }
    __syncthreads();
}

__device__ __forceinline__ void preload_x(const float* __restrict__ xp, int pm, int pn, pg8::f32x4 (&acc)[2][2][4][2]) {
    if (pm < 0) return;
    const int t = threadIdx.x, wid = t >> 6, lane = t & 63, wr = wid >> 2, wc = wid & 3, fr = lane & 15, fq = lane >> 4;
    const int row0 = pm * 256 + wr * 64 + fr, col0 = pn * 256 + wc * 32 + 4 * fq;
#pragma unroll
    for (int ai = 0; ai < 2; ++ai)
#pragma unroll
        for (int m = 0; m < 4; ++m) { const size_t off = (size_t)(row0 + ai * 128 + m * 16) * DM + col0;
#pragma unroll
            for (int bj = 0; bj < 2; ++bj)
#pragma unroll
                for (int n = 0; n < 2; ++n) acc[ai][bj][m][n] = __builtin_nontemporal_load((const pg8::f32x4*)(xp + off + bj * 128 + n * 16)); }
}
struct Order1 {
    static constexpr int NUNITS = 65 * 9;
    int G, c; unsigned* cnt; int s_pm, s_pn; unsigned xcc, nloc;
    __device__ __forceinline__ bool next(int i, pg8::Unit& u) const {
        const int L = i * G + c; if (L >= NUNITS) return false;
        if (L < 512) { pg8::StaticOrder T; T.init(64 * 256, 8 * 256, 512, L); T.next(0, u);
            if (L >= 256) u.pn = 4 + ((u.pn - 4 + 2) & 3);
            return true; }
        const int j = L - 512; if (j < 64) { u.pm = j; u.pn = 8; } else { u.pm = 64; u.pn = j - 64; }
        return true;
    }
    __device__ __forceinline__ void init(int G_, int c_, unsigned* cnt_, unsigned xcc_, unsigned nloc_) { G = G_; c = c_; cnt = cnt_; xcc = xcc_; nloc = nloc_; s_pm = -1; s_pn = -1; pg8::Unit u; if (next(1, u)) { s_pm = u.pm; s_pn = u.pn; } }
    __device__ __forceinline__ void a_ready(const pg8::Unit&) const {}
    __device__ __forceinline__ void done(const pg8::Unit& u) const {
        if (cnt != nullptr && u.pm == s_pm && u.pn == s_pn) {
            asm volatile("s_waitcnt vmcnt(0)" ::: "memory");
            if ((threadIdx.x & 63) == 0) {
                const unsigned old = __hip_atomic_fetch_add(cnt + 64 * xcc, 1u, __ATOMIC_RELAXED, __HIP_MEMORY_SCOPE_AGENT);
                if (old + 1u == 8u * nloc) {
                    __builtin_amdgcn_fence(__ATOMIC_RELEASE, "agent");
                    asm volatile("s_waitcnt vmcnt(0)" ::: "memory");
                    __hip_atomic_fetch_add(cnt + 64 * 16, 1u, __ATOMIC_RELAXED, __HIP_MEMORY_SCOPE_AGENT);
                }
            }
        }
    }
};

template <int PH>
__global__ void __launch_bounds__(512, 2) mk_fwd(Args a) {
    extern __shared__ __attribute__((aligned(16))) unsigned char lds_raw[];
    LAS unsigned char* lds = (LAS unsigned char*)lds_raw;
    const int G = gridDim.x;
    const bool early = (G == 256);
    unsigned* const early_cnt = (unsigned*)(a.ws + WS_BAR) + XCD_BAR_WORDS;
    XcdBarrier bar; bar.bar = (unsigned*)(a.ws + WS_BAR); bar.x = 0; bar.st = nullptr;
    if (PH < 0) {
        if (threadIdx.x < 16) ((LAS unsigned*)(lds + LDS_CTL))[threadIdx.x] = 0u;
        __syncthreads();
        bar = xcd_barrier_post((unsigned*)(a.ws + WS_BAR), (volatile LAS unsigned*)(lds + LDS_CTL));
    }
    if (PH < 0 || PH == 0) { p0_prologue(a, lds); }
    if (PH < 0) { xcd_barrier(bar); }
    if (PH < 0 || PH == 1) {
        pg8::Gemm g{(const pg8::bf16_t*)(a.ws + WS_XB), (const pg8::bf16_t*)(a.ws + WS_WINT), MP, NZ, DM};
        Order1 S; S.init(G, (int)blockIdx.x, (PH < 0 && early) ? early_cnt : nullptr, bar.x, (PH < 0) ? bar.st[0] : 1u);
        pg8::EpiZ E{(pg8::bf16_t*)(a.ws + WS_Z), NZ, (const float*)(a.ws + WS_RSTD), (pg8::bf16_t*)(a.ws + WS_VT), MP};
        pg8::f32x4 acc[2][2][4][2];
        pg8::gemm_phase<pg8::EpiZ, Order1, true, true, false>(lds, g, S, E, acc);
        {
            const int nwg = Order1::NUNITS, rounds = (nwg + G - 1) / G, busy = nwg - (rounds - 1) * G;
            if (PH < 0 && early) {
                if ((int)blockIdx.x >= busy) {
                    if (threadIdx.x == 0) { unsigned sp = 0u; while (xb_ld(early_cnt + 64 * 16) < bar.st[1]) { __builtin_amdgcn_s_sleep(2); if (++sp > (1u << 22)) break; }
                        __builtin_amdgcn_fence(__ATOMIC_ACQUIRE, "agent"); asm volatile("s_waitcnt vmcnt(0)" ::: "memory"); }
                    __syncthreads();
                    const int j = (int)blockIdx.x - busy, nidle = G - busy;
                    if (j < 256) attn_item(a, lds, j >> 1, j & 1, 2);
                    for (int hj = j; hj < 2 * (256 - nidle); hj += nidle) { const int it = nidle + (hj >> 1); attn_item(a, lds, it >> 1, it & 1, hj & 1); }
                }
            }
        }
    }
    if (PH < 0) { xcd_barrier(bar); }
    if (PH < 0 || PH == 2) {
        for (int it = blockIdx.x; it < 256; it += G) {
            if (!(PH < 0 && early)) attn_item(a, lds, it >> 1, it & 1, 2);
            SampleRegs R; sample_load(a, it >> 1, it & 1, R);
            sample_item(a, lds, it >> 1, it & 1, R);
            PoolRegs PR; pool_load(a, it >> 1, it & 1, PR);
            pool_item(a, lds, it >> 1, it & 1, PR);
        }
    }
    pg8::f32x4 acc3[2][2][4][2];
    pg8::Unit u3; u3.pm = -1; u3.pn = -1;
    if (PH < 0) {
        pg8::StaticOrder S3; S3.init(SEQ, DM, G, (int)blockIdx.x); const bool has3 = S3.next(0, u3); if (!has3) { u3.pm = -1; u3.pn = -1; }
        asm volatile("s_waitcnt vmcnt(0)" ::: "memory");
        __syncthreads();
        if (threadIdx.x >= 64) preload_x(a.xp, u3.pm, u3.pn, acc3);
        if (threadIdx.x == 0) xcd_barrier_protocol(bar);
        if (threadIdx.x < 64) preload_x(a.xp, u3.pm, u3.pn, acc3);
        __syncthreads();
    }
    if (PH < 0 || PH == 3) {
        pg8::Gemm g{(const pg8::bf16_t*)(a.ws + WS_MIX), (const pg8::bf16_t*)(a.ws + WS_WOUTT), SEQ, DM, DM};
        pg8::StaticOrder S; S.init(SEQ, DM, G, (int)blockIdx.x);
        pg8::EpiRes E{a.xp, a.out + O_YP, DM, u3.pm, u3.pn};
        pg8::gemm_phase<pg8::EpiRes, pg8::StaticOrder, true, true, (PH < 0)>(lds, g, S, E, acc3);
        __syncthreads();
        for (int piece = blockIdx.x; piece < 256; piece += G) sample_out_piece(a, lds, piece);
    }
}

extern "C" void kernel_launch(void* const* d_in, const int* in_sizes, int n_in, void* d_out, int out_size, void* d_ws, size_t ws_size, hipStream_t stream) {
    static int grid = 0;
    if (grid == 0) {
        if (n_in != 13 || (size_t)out_size != O_END || ws_size < WS_END) { fprintf(stderr, "kernel_launch: unexpected shapes (n_in %d out %d ws %zu)\n", n_in, out_size, ws_size); grid = -1; return; }
        int dev = 0, cus = 0, per_cu = 0;
        hipGetDevice(&dev); hipDeviceGetAttribute(&cus, hipDeviceAttributeMultiprocessorCount, dev);
#if ONE_LAUNCH
        hipFuncSetAttribute((const void*)mk_fwd<-1>, hipFuncAttributeMaxDynamicSharedMemorySize, LDS_BYTES);
        hipOccupancyMaxActiveBlocksPerMultiprocessor(&per_cu, (const void*)mk_fwd<-1>, 512, LDS_BYTES);
#else
        hipFuncSetAttribute((const void*)mk_fwd<0>, hipFuncAttributeMaxDynamicSharedMemorySize, LDS_BYTES);
        hipFuncSetAttribute((const void*)mk_fwd<1>, hipFuncAttributeMaxDynamicSharedMemorySize, LDS_BYTES);
        hipFuncSetAttribute((const void*)mk_fwd<2>, hipFuncAttributeMaxDynamicSharedMemorySize, LDS_BYTES);
        hipFuncSetAttribute((const void*)mk_fwd<3>, hipFuncAttributeMaxDynamicSharedMemorySize, LDS_BYTES);
        per_cu = 1;
#endif
        if (per_cu < 1 || cus < 1) { fprintf(stderr, "kernel_launch: occupancy query gives %d blocks/CU on %d CUs\n", per_cu, cus); grid = -1; return; }
        grid = cus;
    }
    if (grid < 0) return;
    Args a{};
    a.xp = (const float*)d_in[0]; a.xs = (const float*)d_in[1]; a.ck = (const float*)d_in[2]; a.cv = (const float*)d_in[3]; a.sp = (const float*)d_in[4];
    a.normw = (const float*)d_in[5]; a.win = (const float*)d_in[6]; a.qnw = (const float*)d_in[7]; a.knw = (const float*)d_in[8]; a.sinks = (const float*)d_in[9];
    a.wpool = (const float*)d_in[10]; a.pscale = (const float*)d_in[11]; a.wout = (const float*)d_in[12];
    a.out = (float*)d_out; a.ws = (unsigned char*)d_ws;
#if ONE_LAUNCH
    hipMemsetAsync((char*)d_ws + WS_BAR, 0, (size_t)BAR_WORDS * 4, stream);
    void* args[] = {&a};
    hipError_t e = hipLaunchCooperativeKernel((const void*)mk_fwd<-1>, dim3(grid), dim3(512), args, LDS_BYTES, stream);
    if (e != hipSuccess) fprintf(stderr, "cooperative launch failed: %s (grid %d)\n", hipGetErrorString(e), grid);
#else
    hipLaunchKernelGGL(mk_fwd<0>, dim3(grid), dim3(512), LDS_BYTES, stream, a);
    hipLaunchKernelGGL(mk_fwd<1>, dim3(grid), dim3(512), LDS_BYTES, stream, a);
    hipLaunchKernelGGL(mk_fwd<2>, dim3(grid), dim3(512), LDS_BYTES, stream, a);
    hipLaunchKernelGGL(mk_fwd<3>, dim3(grid), dim3(512), LDS_BYTES, stream, a);
#endif
}
```

```cpp
#include <hip/hip_runtime.h>
#include <cstdio>
#include <cstdint>
#ifndef ONE_LAUNCH
#define ONE_LAUNCH 1
#endif
namespace pg8 {
#define PG8_LAS __attribute__((address_space(3)))
typedef unsigned short bf16_t;
typedef short bf16x8 __attribute__((ext_vector_type(8)));
typedef float f32x4 __attribute__((ext_vector_type(4)));
typedef unsigned u32x4 __attribute__((ext_vector_type(4)));
constexpr int BM = 256, BK = 64, HALF = 128, HTB = HALF * BK * 2  , STAGE_BYTES = 8 * HTB, NXCD = 8, WGM = 8;

__host__ __device__ __forceinline__ int lds_byte(int r, int c) { const int st = (r >> 4) * 2 + (c >> 5), rr = r & 15, cc = c & 31, ob = rr * 64 + cc * 2; return st * 1024 + (ob ^ (((ob >> 9) & 1) << 5)); }
__host__ __device__ __forceinline__ void stage_rc(int b, int& R, int& C) { const int st = b / 1024, sb = b % 1024, swz = sb ^ (((sb >> 9) & 1) << 5); R = (st >> 1) * 16 + swz / 64; C = (st & 1) * 32 + (swz % 64) / 2; }
__host__ __device__ __forceinline__ int perm32(int rho) { const int n = rho >> 4, i = rho & 15; return 8 * (i >> 2) + 4 * n + (i & 3); }

struct Unit { int pm, pn; };
struct Gemm { const bf16_t* A; const bf16_t* Bt; int M, N, K; };

struct StaticOrder {
    int nM, nN, nwg, G, c;
    __host__ __device__ void init(int M, int N, int G_, int c_) { nM = M / BM; nN = N / BM; nwg = nM * nN; G = G_; c = c_; }
    __host__ __device__ bool next(int i, Unit& u) const {
        const long L = (long)i * G + c; if (L >= nwg) return false;
        int wgid = (int)L; { const int q = nwg / NXCD, r = nwg % NXCD, xcd = wgid % NXCD, off = wgid / NXCD; wgid = (xcd < r ? xcd * (q + 1) : r * (q + 1) + (xcd - r) * q) + off; }
        const int nig = WGM * nN, gid = wgid / nig, fm = gid * WGM, gsz = (nM - fm) < WGM ? (nM - fm) : WGM;
        u.pm = fm + ((wgid % nig) % gsz); u.pn = (wgid % nig) / gsz; return true;
    }
    __device__ __forceinline__ void a_ready(const Unit&) const {}
    __device__ __forceinline__ void done(const Unit&) const {}
};

__device__ __forceinline__ unsigned cvt_pk_bf16(float lo, float hi) { unsigned r; asm volatile("v_cvt_pk_bf16_f32 %0, %1, %2" : "=v"(r) : "v"(lo), "v"(hi)); return r; }
struct EpiZ {
    static constexpr bool PERM = true, AFTER_DRAIN = false;
    bf16_t* Z; int ldc; const float* rstd; bf16_t* VT; int vt_ld;
    __device__ __forceinline__ void operator()(const f32x4 (&acc)[2][2][4][2], const Unit& u, int wr, int wc, int fr, int fq) const {
        const int row0 = u.pm * BM + wr * 64 + fr, col0 = u.pn * BM + wc * 32 + 8 * fq;
        const bool gate = (u.pn == 3) | (u.pn == 4) | (u.pn >= 7);
#pragma unroll
        for (int ai = 0; ai < 2; ++ai)
#pragma unroll
            for (int m = 0; m < 4; ++m) {
                const int row = row0 + ai * HALF + m * 16;
                bf16_t* rowp = Z + (size_t)row * ldc + col0;
#pragma unroll
                for (int bj = 0; bj < 2; ++bj) { f32x4 v0 = acc[ai][bj][m][0], v1 = acc[ai][bj][m][1];
                    if (gate) {
#pragma unroll
                        for (int j = 0; j < 4; ++j) { v0[j] = v0[j] * __builtin_amdgcn_rcpf(1.0f + __builtin_amdgcn_exp2f(v0[j] * -1.4426950408889634f)); v1[j] = v1[j] * __builtin_amdgcn_rcpf(1.0f + __builtin_amdgcn_exp2f(v1[j] * -1.4426950408889634f)); } }
                    u32x4 w; w.x = cvt_pk_bf16(v0[0], v0[1]); w.y = cvt_pk_bf16(v0[2], v0[3]); w.z = cvt_pk_bf16(v1[0], v1[1]); w.w = cvt_pk_bf16(v1[2], v1[3]);
                    *(u32x4*)(rowp + bj * HALF) = w;
                    if (bj == 1 && u.pn == 2) {
                        bf16_t* vt = VT + (size_t)(wc * 32 + 8 * fq) * vt_ld + row;
                        vt[0 * (size_t)vt_ld] = (bf16_t)(w.x & 0xffffu); vt[1 * (size_t)vt_ld] = (bf16_t)(w.x >> 16);
                        vt[2 * (size_t)vt_ld] = (bf16_t)(w.y & 0xffffu); vt[3 * (size_t)vt_ld] = (bf16_t)(w.y >> 16);
                        vt[4 * (size_t)vt_ld] = (bf16_t)(w.z & 0xffffu); vt[5 * (size_t)vt_ld] = (bf16_t)(w.z >> 16);
                        vt[6 * (size_t)vt_ld] = (bf16_t)(w.w & 0xffffu); vt[7 * (size_t)vt_ld] = (bf16_t)(w.w >> 16);
                    } } }
    }
};
struct EpiRes {
    static constexpr bool PERM = false, AFTER_DRAIN = false;
    const float* base; float* out; int ldc; int pre_pm, pre_pn;
    __device__ __forceinline__ void operator()(const f32x4 (&acc)[2][2][4][2], const Unit& u, int wr, int wc, int fr, int fq) const {
        const int row0 = u.pm * BM + wr * 64 + fr, col0 = u.pn * BM + wc * 32 + 4 * fq;
        if (u.pm == pre_pm && u.pn == pre_pn) {
#pragma unroll
            for (int ai = 0; ai < 2; ++ai)
#pragma unroll
                for (int m = 0; m < 4; ++m) { const size_t off = (size_t)(row0 + ai * HALF + m * 16) * ldc + col0;
#pragma unroll
                    for (int bj = 0; bj < 2; ++bj)
#pragma unroll
                        for (int n = 0; n < 2; ++n) __builtin_nontemporal_store(acc[ai][bj][m][n], (f32x4*)(out + off + bj * HALF + n * 16)); }
            return;
        }
#pragma unroll
        for (int ai = 0; ai < 2; ++ai) {
            f32x4 xv[4][2][2];
#pragma unroll
            for (int m = 0; m < 4; ++m) { const size_t off = (size_t)(row0 + ai * HALF + m * 16) * ldc + col0;
#pragma unroll
                for (int bj = 0; bj < 2; ++bj)
#pragma unroll
                    for (int n = 0; n < 2; ++n) xv[m][bj][n] = *(const f32x4*)(base + off + bj * HALF + n * 16); }
#pragma unroll
            for (int m = 0; m < 4; ++m) { const size_t off = (size_t)(row0 + ai * HALF + m * 16) * ldc + col0;
#pragma unroll
                for (int bj = 0; bj < 2; ++bj)
#pragma unroll
                    for (int n = 0; n < 2; ++n) *(f32x4*)(out + off + bj * HALF + n * 16) = xv[m][bj][n] + acc[ai][bj][m][n]; }
        }
    }
};
template <class Epi, class Sched, bool ALIGN_EPI = false, bool SP2 = false, bool PRE = false>
__device__ __forceinline__ void gemm_phase(PG8_LAS unsigned char* lds, const Gemm g, const Sched& S, const Epi& E, f32x4 (&acc)[2][2][4][2]) {
    int tid_ = threadIdx.x; asm volatile("" : "+v"(tid_));
    const int tid = tid_, wid = __builtin_amdgcn_readfirstlane(tid >> 6), lane = tid & 63, wr = wid >> 2, wc = wid & 3, fr = lane & 15, fq = lane >> 4;
    const int K = g.K, nt = K / BK;
    unsigned voffA[2], voffB[2];
#pragma unroll
    for (int i = 0; i < 2; ++i) { int R, C; stage_rc(tid * 16 + i * 8192, R, C); const int Rb = Epi::PERM ? ((R & ~31) + perm32(R & 31)) : R;
        voffA[i] = (unsigned)(R * K + C) * 2u; voffB[i] = (unsigned)(Rb * K + C) * 2u; }
    const size_t kstep = (size_t)(BK * 2);
    const size_t hstep = (size_t)HALF * K * 2;
    const size_t tstep = 2 * hstep;
    const unsigned ldsw = (unsigned)wid * 1024u;
    const int aoff = lds_byte(wr * 64 + fr, fq * 8), boff = lds_byte(wc * 32 + fr, fq * 8);
#define PG8_SA(b, h) (((b) * 2 + (h)) * HTB)
#define PG8_SB(b, h) ((4 + (b) * 2 + (h)) * HTB)
#define PG8_STAGE(bufoff, gbase, voff) do { _Pragma("unroll") for (int _i = 0; _i < 2; ++_i) \
        __builtin_amdgcn_global_load_lds((const unsigned*)((const char*)(gbase) + (voff)[_i]), (PG8_LAS unsigned*)(lds + (bufoff) + ldsw + _i * 8192), 16, 0, 0); } while (0)
#define PG8_LDA(dst, b, h) do { _Pragma("unroll") for (int m = 0; m < 4; ++m) _Pragma("unroll") for (int k = 0; k < 2; ++k) dst[m][k] = *(const PG8_LAS bf16x8*)(lds + PG8_SA(b, h) + aoff + m * 2048 + k * 1024); } while (0)
#define PG8_LDB(dst, b, h) do { _Pragma("unroll") for (int n = 0; n < 2; ++n) _Pragma("unroll") for (int k = 0; k < 2; ++k) dst[n][k] = *(const PG8_LAS bf16x8*)(lds + PG8_SB(b, h) + boff + n * 2048 + k * 1024); } while (0)
#define PG8_MMA(ai, bj, At, Bt) do { __builtin_amdgcn_s_setprio(1); _Pragma("unroll") for (int m = 0; m < 4; ++m) _Pragma("unroll") for (int n = 0; n < 2; ++n) _Pragma("unroll") for (int k = 0; k < 2; ++k) \
        acc[ai][bj][m][n] = __builtin_amdgcn_mfma_f32_16x16x32_bf16(Bt[n][k], At[m][k], acc[ai][bj][m][n], 0, 0, 0); __builtin_amdgcn_s_setprio(0); } while (0)
#define PG8_WAIT_V(n) asm volatile("s_waitcnt vmcnt(" #n ")" ::: "memory")
#define PG8_WAIT_L(n) asm volatile("s_waitcnt lgkmcnt(" #n ")" ::: "memory")
#define PG8_BAR __builtin_amdgcn_s_barrier()
#define PG8_SCHED __builtin_amdgcn_sched_barrier(0)
    Unit cur, nxt; int ui = 0;
    if (!S.next(0, cur)) return;
#pragma unroll
    for (int a = 0; a < 2; ++a)
#pragma unroll
        for (int b = 0; b < 2; ++b)
#pragma unroll
            for (int m = 0; m < 4; ++m)
#pragma unroll
                for (int n = 0; n < 2; ++n) { if constexpr (PRE) asm volatile("" : "+v"(acc[a][b][m][n]));
                                              else acc[a][b][m][n] = (f32x4){0.f, 0.f, 0.f, 0.f}; }
    bf16x8 At[4][2], B0[2][2], B1[2][2];
    const char* cA = (const char*)g.A + (size_t)cur.pm * tstep; const char* cB = (const char*)g.Bt + (size_t)cur.pn * tstep;
    S.a_ready(cur);
    if constexpr (SP2) {
        PG8_STAGE(PG8_SB(0, 0), cB, voffB); PG8_STAGE(PG8_SB(0, 1), cB + hstep, voffB); PG8_STAGE(PG8_SA(0, 0), cA, voffA); PG8_STAGE(PG8_SA(0, 1), cA + hstep, voffA);
        if (wr == 1) PG8_BAR;
        PG8_WAIT_V(2); PG8_BAR;
        PG8_STAGE(PG8_SB(1, 0), cB + kstep, voffB); PG8_STAGE(PG8_SA(1, 0), cA + kstep, voffA); PG8_STAGE(PG8_SB(1, 1), cB + hstep + kstep, voffB);
        PG8_WAIT_V(6); PG8_BAR;
    } else {
        PG8_STAGE(PG8_SB(0, 0), cB, voffB); PG8_STAGE(PG8_SA(0, 0), cA, voffA); PG8_STAGE(PG8_SB(0, 1), cB + hstep, voffB); PG8_STAGE(PG8_SA(0, 1), cA + hstep, voffA);
        if (wr == 1) PG8_BAR;
        PG8_WAIT_V(4); PG8_BAR;
        PG8_STAGE(PG8_SB(1, 0), cB + kstep, voffB); PG8_STAGE(PG8_SA(1, 0), cA + kstep, voffA); PG8_STAGE(PG8_SB(1, 1), cB + hstep + kstep, voffB);
        PG8_WAIT_V(6); PG8_BAR;
    }
    for (;;) {
        const bool has_next = S.next(ui + 1, nxt);
        const char* nA = has_next ? (const char*)g.A + (size_t)nxt.pm * tstep : cA; const char* nB = has_next ? (const char*)g.Bt + (size_t)nxt.pn * tstep : cB;
        for (int t = 0; t < nt; t += 2) {
            const bool last = (t == nt - 2);
            const char* a1 = cA + (size_t)(t + 1) * kstep;
            const char* a2 = last ? nA : cA + (size_t)(t + 2) * kstep; const char* b2 = last ? nB : cB + (size_t)(t + 2) * kstep;
            const char* a3 = a2 + kstep; const char* b3 = b2 + kstep;
            if (last && has_next) S.a_ready(nxt);
            if constexpr (SP2) {
            PG8_LDB(B0, 0, 0); PG8_LDB(B1, 0, 1); PG8_SCHED; PG8_LDA(At, 0, 0); PG8_STAGE(PG8_SA(1, 1), a1 + hstep, voffA);
            PG8_WAIT_V(8); PG8_WAIT_L(0); PG8_BAR; PG8_MMA(0, 0, At, B0); PG8_MMA(0, 1, At, B1); PG8_BAR; PG8_SCHED;
            PG8_LDA(At, 0, 1); PG8_STAGE(PG8_SB(0, 0), b2, voffB); PG8_STAGE(PG8_SB(0, 1), b2 + hstep, voffB); PG8_STAGE(PG8_SA(0, 0), a2, voffA);
            PG8_WAIT_V(8); PG8_WAIT_L(0); PG8_BAR; PG8_MMA(1, 0, At, B0); PG8_MMA(1, 1, At, B1); PG8_BAR; PG8_SCHED;
            PG8_LDB(B0, 1, 0); PG8_LDB(B1, 1, 1); PG8_SCHED; PG8_LDA(At, 1, 0); PG8_STAGE(PG8_SA(0, 1), a2 + hstep, voffA);
            PG8_WAIT_V(8); PG8_WAIT_L(0); PG8_BAR; PG8_MMA(0, 0, At, B0); PG8_MMA(0, 1, At, B1); PG8_BAR; PG8_SCHED;
            PG8_LDA(At, 1, 1); PG8_STAGE(PG8_SB(1, 0), b3, voffB); PG8_STAGE(PG8_SB(1, 1), b3 + hstep, voffB); PG8_STAGE(PG8_SA(1, 0), a3, voffA);
            PG8_WAIT_V(8); PG8_WAIT_L(0); PG8_BAR; PG8_MMA(1, 0, At, B0); PG8_MMA(1, 1, At, B1); PG8_BAR; PG8_SCHED;
            } else {
            PG8_LDB(B0, 0, 0); PG8_SCHED; PG8_LDA(At, 0, 0); PG8_STAGE(PG8_SA(1, 1), a1 + hstep, voffA);
            PG8_WAIT_L(8); PG8_BAR; PG8_WAIT_L(0); PG8_MMA(0, 0, At, B0); PG8_BAR; PG8_SCHED;
            PG8_LDB(B1, 0, 1); PG8_STAGE(PG8_SB(0, 0), b2, voffB);
            PG8_BAR; PG8_WAIT_L(0); PG8_MMA(0, 1, At, B1); PG8_BAR;
            PG8_LDA(At, 0, 1); PG8_STAGE(PG8_SA(0, 0), a2, voffA);
            PG8_BAR; PG8_WAIT_L(0); PG8_MMA(1, 0, At, B0); PG8_BAR; PG8_SCHED;
            PG8_STAGE(PG8_SB(0, 1), b2 + hstep, voffB);
            PG8_WAIT_V(6); PG8_BAR; PG8_MMA(1, 1, At, B1); PG8_BAR;
            PG8_LDB(B0, 1, 0); PG8_SCHED; PG8_LDA(At, 1, 0); PG8_STAGE(PG8_SA(0, 1), a2 + hstep, voffA);
            PG8_WAIT_L(8); PG8_BAR; PG8_WAIT_L(0); PG8_MMA(0, 0, At, B0); PG8_BAR; PG8_SCHED;
            PG8_LDB(B1, 1, 1); PG8_STAGE(PG8_SB(1, 0), b3, voffB);
            PG8_BAR; PG8_WAIT_L(0); PG8_MMA(0, 1, At, B1); PG8_BAR;
            PG8_LDA(At, 1, 1); PG8_STAGE(PG8_SA(1, 0), a3, voffA);
            PG8_BAR; PG8_WAIT_L(0); PG8_MMA(1, 0, At, B0); PG8_BAR; PG8_SCHED;
            PG8_STAGE(PG8_SB(1, 1), b3 + hstep, voffB);
            PG8_WAIT_V(6); PG8_BAR; PG8_MMA(1, 1, At, B1); PG8_BAR;
            }
        }
        if constexpr (ALIGN_EPI) { if (wr == 0) PG8_BAR; }
        if constexpr (!Epi::AFTER_DRAIN) { E(acc, cur, wr, wc, fr, fq); S.done(cur); }
        if (!has_next) break;
#pragma unroll
        for (int a = 0; a < 2; ++a)
#pragma unroll
            for (int b = 0; b < 2; ++b)
#pragma unroll
                for (int m = 0; m < 4; ++m)
#pragma unroll
                    for (int n = 0; n < 2; ++n) acc[a][b][m][n] = (f32x4){0.f, 0.f, 0.f, 0.f};
        cur = nxt; cA = nA; cB = nB; ++ui;
        if constexpr (ALIGN_EPI) { if (wr == 1) PG8_BAR; }
    }
    PG8_WAIT_V(0);
    if constexpr (!ALIGN_EPI) { if (wr == 0) PG8_BAR; }
    PG8_BAR;
    if constexpr (Epi::AFTER_DRAIN) { E.fused(acc, cur, wr, wc, fr, fq, lds, wid, lane); S.done(cur); }
#undef PG8_SA
#undef PG8_SB
#undef PG8_STAGE
#undef PG8_LDA
#undef PG8_LDB
#undef PG8_MMA
#undef PG8_WAIT_V
#undef PG8_WAIT_L
#undef PG8_BAR
#undef PG8_SCHED
}
}

#define LAS __attribute__((address_space(3)))
#define XB_TMO      128
#define XB_XCNT(j)  (256  + 64 * (j))
#define XB_XSUB(j)  (1280 + 64 * (j))
#define XB_XGEN(j)  (2304 + 64 * (j))
#define XB_TOP      3328
#define XB_TOPGEN   3392
#define XCD_BAR_WORDS 3456
#define XB_SPIN_CAP (1u << 18)

__device__ __forceinline__ unsigned xb_ld(unsigned* p)              { return __hip_atomic_load(p, __ATOMIC_RELAXED, __HIP_MEMORY_SCOPE_AGENT); }
__device__ __forceinline__ unsigned xb_add(unsigned* p, unsigned v) { return __hip_atomic_fetch_add(p, v, __ATOMIC_RELAXED, __HIP_MEMORY_SCOPE_AGENT); }
__device__ __forceinline__ unsigned xb_xcc_id() { return (unsigned)__builtin_amdgcn_s_getreg((3 << 11) | 20) & 0xFu; }
#define XB_SPIN(cond, bar) do { unsigned _sp = 0; while (cond) { __builtin_amdgcn_s_sleep(1); \
    if ((++_sp & 255u) == 0u) { if (xb_ld(&(bar)[XB_TMO])) break; if (_sp > XB_SPIN_CAP) { atomicAdd(&(bar)[XB_TMO], 1u); break; } } } } while (0)

struct XcdBarrier {
    unsigned* bar; unsigned x;
    volatile LAS unsigned* st;
};

__device__ __forceinline__ XcdBarrier xcd_barrier_post(unsigned* bar, volatile LAS unsigned* st) {
    XcdBarrier b; b.bar = bar; b.x = xb_xcc_id(); b.st = st;
    if (threadIdx.x == 0) (void)xb_add(&bar[XB_XCNT(b.x)], 1u);
    return b;
}
__device__ __forceinline__ void xcd_barrier_complete(unsigned* bar, unsigned x, unsigned& nloc, unsigned& nx) {
    const unsigned G = gridDim.x * gridDim.y * gridDim.z;
    unsigned sum, cnt, mine, sp = 0u;
    for (;;) {
        sum = 0u; cnt = 0u; mine = 0u;
#pragma unroll
        for (unsigned j = 0; j < 16; ++j) { const unsigned c = xb_ld(&bar[XB_XCNT(j)]); sum += c; cnt += (c > 0u) ? 1u : 0u; mine = (j == x) ? c : mine; }
        if (sum == G) break;
        __builtin_amdgcn_s_sleep(1);
        if ((++sp & 255u) == 0u) { if (xb_ld(&bar[XB_TMO])) break; if (sp > XB_SPIN_CAP) { atomicAdd(&bar[XB_TMO], 1u); break; } }
    }
    nloc = mine > 0u ? mine : 1u; nx = cnt > 0u ? cnt : 1u;
}

__device__ __forceinline__ void xcd_barrier_protocol(const XcdBarrier& b) {
    {
        unsigned* bar = b.bar;
        __builtin_amdgcn_s_waitcnt(0);
        unsigned nloc = b.st[0], nx = b.st[1];
        if (nloc == 0u) { xcd_barrier_complete(bar, b.x, nloc, nx); b.st[0] = nloc; b.st[1] = nx; }
        const unsigned old = xb_add(&bar[XB_XSUB(b.x)], 1u);
        const unsigned gen = old / nloc;
        if (old + 1u == (gen + 1u) * nloc) {
            __builtin_amdgcn_fence(__ATOMIC_RELEASE, "agent");
            asm volatile("s_waitcnt vmcnt(0)" ::: "memory");
            const unsigned og = xb_add(&bar[XB_TOP], 1u);
            const unsigned tg = og / nx;
            if (og + 1u == (tg + 1u) * nx) xb_add(&bar[XB_TOPGEN], 1u);
            else XB_SPIN(xb_ld(&bar[XB_TOPGEN]) == tg, bar);
            __builtin_amdgcn_fence(__ATOMIC_ACQUIRE, "agent");
            xb_add(&bar[XB_XGEN(b.x)], 1u);
            asm volatile("s_waitcnt vmcnt(0)" ::: "memory");
        } else {
            XB_SPIN(xb_ld(&bar[XB_XGEN(b.x)]) == gen, bar);
            __builtin_amdgcn_fence(__ATOMIC_ACQUIRE, "agent");
            asm volatile("s_waitcnt vmcnt(0)" ::: "memory");
        }
    }
}
__device__ __forceinline__ void xcd_barrier(const XcdBarrier& b) {
    asm volatile("s_waitcnt vmcnt(0)" ::: "memory");
    __syncthreads();
    if (threadIdx.x == 0) xcd_barrier_protocol(b);
    __syncthreads();
}

typedef unsigned short bf16_t;
typedef short bf16x8 __attribute__((ext_vector_type(8)));
typedef short s16x4 __attribute__((ext_vector_type(4)));
typedef float f32x4 __attribute__((ext_vector_type(4)));
typedef float f32x16 __attribute__((ext_vector_type(16)));
typedef unsigned u32x4 __attribute__((ext_vector_type(4)));
typedef unsigned u32x2 __attribute__((ext_vector_type(2)));

constexpr int DM = 1024, SEQ = 16384, NSMP = 128, MP = 16640  , NZ = 2304;
constexpr int ZQ = 0, ZK = 512, ZV = 640, ZGA = 768, ZU = 1280, ZGP = 1792;
constexpr float EPS = 1e-6f, LOG2E = 1.4426950408889634f;
constexpr int LDS_CTL = 139264, LDS_BYTES = LDS_CTL + 64;
constexpr size_t WS_XB = 0;
constexpr size_t WS_RSTD = WS_XB + (size_t)MP * DM * 2;
constexpr size_t WS_WINT = WS_RSTD + (size_t)MP * 4;
constexpr size_t WS_WOUTT = WS_WINT + (size_t)NZ * DM * 2;
constexpr size_t WS_WPT = WS_WOUTT + (size_t)DM * DM * 2;
constexpr size_t WS_Z = WS_WPT + (size_t)4 * 128 * 128 * 2;
constexpr size_t WS_VT = WS_Z + (size_t)MP * NZ * 2;
constexpr size_t WS_MIX = WS_VT + (size_t)128 * MP * 2;
constexpr size_t WS_BAR = WS_MIX + (size_t)MP * DM * 2;
constexpr int BAR_WORDS = XCD_BAR_WORDS + 64 * 17;
constexpr size_t WS_END = WS_BAR + (size_t)BAR_WORDS * 4;
constexpr size_t O_YP = 0, O_YS = O_YP + (size_t)SEQ * DM, O_KP = O_YS + (size_t)NSMP * DM, O_VP = O_KP + 128 * 128, O_PP = O_VP + 128 * 128,
                 O_KS = O_PP + 15 * 512, O_VS = O_KS + (size_t)NSMP * 128 * 128, O_PS = O_VS + (size_t)NSMP * 128 * 128, O_END = O_PS + (size_t)NSMP * 15 * 512;

struct Args {
    const float *xp, *xs, *ck, *cv, *sp, *normw, *win, *qnw, *knw, *sinks, *wpool, *pscale, *wout;
    float* out; unsigned char* ws;
};

__device__ __forceinline__ float bf2f(unsigned b) { return __uint_as_float(b << 16); }
__device__ __forceinline__ unsigned pk2(float lo, float hi) { unsigned r; asm volatile("v_cvt_pk_bf16_f32 %0, %1, %2" : "=v"(r) : "v"(lo), "v"(hi)); return r; }
__device__ __forceinline__ float wave_sum(float v) {
#pragma unroll
    for (int o = 32; o > 0; o >>= 1) v += __shfl_xor(v, o);
    return v;
}
__device__ __forceinline__ float wave_max(float v) {
#pragma unroll
    for (int o = 32; o > 0; o >>= 1) v = fmaxf(v, __shfl_xor(v, o));
    return v;
}
__device__ __forceinline__ float silu(float x) { return x * __builtin_amdgcn_rcpf(1.0f + __expf(-x)); }
__device__ __forceinline__ void unpack8(const u32x4 w, float (&f)[8]) {
    f[0] = __uint_as_float(w.x << 16); f[1] = __uint_as_float(w.x & 0xffff0000u); f[2] = __uint_as_float(w.y << 16); f[3] = __uint_as_float(w.y & 0xffff0000u);
    f[4] = __uint_as_float(w.z << 16); f[5] = __uint_as_float(w.z & 0xffff0000u); f[6] = __uint_as_float(w.w << 16); f[7] = __uint_as_float(w.w & 0xffff0000u);
}

struct TileDesc { const float* src; bf16_t* dst; const float* kscale; const float* nscale; int K, N, k0, n0; };
__device__ __forceinline__ TileDesc tile_desc(const Args& a, int it) {
    constexpr int I_IN = 16 * 36, I_OUT = 16 * 16;
    TileDesc t;
    if (it < I_IN) { t.src = a.win; t.dst = (bf16_t*)(a.ws + WS_WINT); t.kscale = a.normw; t.nscale = nullptr; t.K = DM; t.N = NZ; t.k0 = (it & 15) * 64; t.n0 = (it >> 4) * 64; return t; }
    it -= I_IN;
    if (it < I_OUT) { t.src = a.wout; t.dst = (bf16_t*)(a.ws + WS_WOUTT); t.kscale = nullptr; t.nscale = nullptr; t.K = DM; t.N = DM; t.k0 = (it & 15) * 64; t.n0 = (it >> 4) * 64; return t; }
    it -= I_OUT;
    { const int g = it >> 2; t.src = a.wpool + g * 16384; t.dst = (bf16_t*)(a.ws + WS_WPT) + g * 16384; t.kscale = nullptr; t.nscale = a.pscale + g * 128; t.K = 128; t.N = 128; t.k0 = ((it >> 1) & 1) * 64; t.n0 = (it & 1) * 64; }
    return t;
}
__device__ __forceinline__ void p0_prologue(const Args& a, LAS unsigned char* lds) {
    int tid_ = threadIdx.x; asm volatile("" : "+v"(tid_)); const int tid = tid_, lane = tid & 63, wave = tid >> 6;
    bf16_t* XB = (bf16_t*)(a.ws + WS_XB);
    constexpr int NITEMS = 16 * 36 + 16 * 16 + 16;
    LAS float* scr = (LAS float*)lds;
    for (int it0 = blockIdx.x; it0 < NITEMS; it0 += 4 * gridDim.x) {
        f32x4 va[4], vb[4];
#pragma unroll
        for (int j = 0; j < 4; ++j) { const int it = it0 + j * gridDim.x;
            if (it < NITEMS) { const TileDesc t = tile_desc(a, it); const int kr = tid >> 3, c = tid & 7; const float* s = t.src + (size_t)(t.k0 + kr) * t.N + t.n0 + c * 8;
                va[j] = __builtin_nontemporal_load((const f32x4*)s); vb[j] = __builtin_nontemporal_load((const f32x4*)(s + 4));
                const float sc = t.kscale ? t.kscale[t.k0 + kr] : 1.0f; va[j] *= sc; vb[j] *= sc;
                if (t.nscale) { va[j] *= *(const f32x4*)(t.nscale + t.n0 + c * 8); vb[j] *= *(const f32x4*)(t.nscale + t.n0 + c * 8 + 4); } } }
#pragma unroll
        for (int j = 0; j < 4; ++j) { const int it = it0 + j * gridDim.x;
            if (it < NITEMS) { const TileDesc t = tile_desc(a, it);
                { const int kr = tid >> 3, c = tid & 7; LAS float* d = scr + kr * 65 + c * 8;
                  d[0] = va[j].x; d[1] = va[j].y; d[2] = va[j].z; d[3] = va[j].w; d[4] = vb[j].x; d[5] = vb[j].y; d[6] = vb[j].z; d[7] = vb[j].w; }
                __syncthreads();
                { const int n = tid >> 3, kc = tid & 7; const LAS float* sp = scr + (kc * 8) * 65 + n;
                  u32x4 o; o.x = pk2(sp[0], sp[65]); o.y = pk2(sp[130], sp[195]); o.z = pk2(sp[260], sp[325]); o.w = pk2(sp[390], sp[455]);
                  *(u32x4*)(t.dst + (size_t)(t.n0 + n) * t.K + t.k0 + kc * 8) = o; }
                __syncthreads(); } }
    }
    const int gw = blockIdx.x * 8 + wave, NGW = gridDim.x * 8;
    for (int m0 = gw; m0 < MP; m0 += 2 * NGW) {
        f32x4 v[2][4];
#pragma unroll
        for (int q = 0; q < 2; ++q) { const int m = m0 + q * NGW;
            if (m < SEQ + NSMP) { const float* xr = (m < SEQ) ? a.xp + (size_t)m * DM : a.xs + (size_t)(m - SEQ) * DM; const f32x4* x4 = (const f32x4*)xr + lane;
#pragma unroll
                for (int j = 0; j < 4; ++j) v[q][j] = __builtin_nontemporal_load(x4 + 64 * j); }
            else {
#pragma unroll
                for (int j = 0; j < 4; ++j) v[q][j] = (f32x4){0.f, 0.f, 0.f, 0.f}; } }
#pragma unroll
        for (int q = 0; q < 2; ++q) { const int m = m0 + q * NGW;
            if (m < MP) { float ss = 0.f;
#pragma unroll
                for (int j = 0; j < 4; ++j) ss += (v[q][j].x * v[q][j].x + v[q][j].y * v[q][j].y) + (v[q][j].z * v[q][j].z + v[q][j].w * v[q][j].w);
                ss = wave_sum(ss);
                const float rs = 1.0f / sqrtf(ss * (1.0f / DM) + EPS);
                unsigned long long* o8 = (unsigned long long*)(XB + (size_t)m * DM) + lane;
#pragma unroll
                for (int j = 0; j < 4; ++j) o8[64 * j] = (unsigned long long)pk2(v[q][j].x * rs, v[q][j].y * rs) | ((unsigned long long)pk2(v[q][j].z * rs, v[q][j].w * rs) << 32); } }
    }
}

constexpr int KS_STRIDE = 144, VS_STRIDE = 520, KS_OFF = 0, VS_OFF = 256 * KS_STRIDE;

__device__ __forceinline__ void attn_item(const Args& a, LAS unsigned char* lds, int qb, int kvh, int hsel) {
    int tid_ = threadIdx.x; asm volatile("" : "+v"(tid_)); const int tid = tid_, lane = tid & 63, wave = __builtin_amdgcn_readfirstlane(tid >> 6);
    const bf16_t* __restrict__ Z = (const bf16_t*)(a.ws + WS_Z); const bf16_t* __restrict__ VT = (const bf16_t*)(a.ws + WS_VT); bf16_t* __restrict__ MIX = (bf16_t*)(a.ws + WS_MIX);
    const int key_base = (qb - 1) * 128;
    const int head = kvh * 4 + ((hsel == 2) ? (wave >> 1) : (2 * hsel + (wave >> 2))), sb0 = (hsel == 2) ? 2 * (wave & 1) : (wave & 3), nsb = (hsel == 2) ? 2 : 1, r = lane & 31, h = lane >> 5;
    u32x4 kw[4], vw[4], qw[4];
#pragma unroll
    for (int i = 0; i < 4; ++i) { const int task = tid + 512 * i, kk = task >> 3, c = task & 7, pos = max(key_base + kk, 0);
        kw[i] = *(const u32x4*)(Z + (size_t)pos * NZ + ZK + kvh * 64 + c * 8); }
#pragma unroll
    for (int i = 0; i < 4; ++i) { const int task = tid + 512 * i, d = task >> 5, c = task & 31, pos = max(key_base + c * 8, 0);
        vw[i] = *(const u32x4*)(VT + (size_t)(kvh * 64 + d) * MP + pos); }
#pragma unroll
    for (int s = 0; s < 4; ++s) qw[s] = *(const u32x4*)(Z + (size_t)(qb * 128 + 32 * sb0 + r) * NZ + ZQ + head * 64 + 16 * s + 8 * h);
    u32x2 pvw[4];
    if (qb == 127) {
#pragma unroll
        for (int i = 0; i < 4; ++i) { const int idx = tid + 512 * i, t = idx >> 4, c4 = idx & 15; pvw[i] = *(const u32x2*)(Z + (size_t)(SEQ - 128 + t) * NZ + ZV + kvh * 64 + c4 * 4); }
    }
    const f32x4 kn0 = *(const f32x4*)(a.knw + (tid & 7) * 8), kn1 = *(const f32x4*)(a.knw + (tid & 7) * 8 + 4);
    const f32x4 kq0 = kn0 * *(const f32x4*)(a.qnw + (tid & 7) * 8), kq1 = kn1 * *(const f32x4*)(a.qnw + (tid & 7) * 8 + 4);
#pragma unroll
    for (int i = 0; i < 4; ++i) {
        const int task = tid + 512 * i, kk = task >> 3, c = task & 7;
        float f[8];
        u32x4 w = kw[i];
        if (key_base + kk < 0) w = (u32x4){0u, 0u, 0u, 0u};
        unpack8(w, f);
        float ss = 0.f;
#pragma unroll
        for (int j = 0; j < 8; ++j) ss += f[j] * f[j];
        ss += __shfl_xor(ss, 1); ss += __shfl_xor(ss, 2); ss += __shfl_xor(ss, 4);
        const float rr = 1.0f / sqrtf(ss * (1.0f / 64.0f) + EPS);
        if (qb == 127 && kk >= 128) {
            float* o = a.out + O_KP + (size_t)((kk - 128) * 2 + kvh) * 64 + c * 8;
            *(f32x4*)o = (f32x4){f[0] * rr * kn0.x, f[1] * rr * kn0.y, f[2] * rr * kn0.z, f[3] * rr * kn0.w}; *(f32x4*)(o + 4) = (f32x4){f[4] * rr * kn1.x, f[5] * rr * kn1.y, f[6] * rr * kn1.z, f[7] * rr * kn1.w};
        }
        f[0] *= rr * kq0.x; f[1] *= rr * kq0.y; f[2] *= rr * kq0.z; f[3] *= rr * kq0.w; f[4] *= rr * kq1.x; f[5] *= rr * kq1.y; f[6] *= rr * kq1.z; f[7] *= rr * kq1.w;
        u32x4 o; o.x = pk2(f[0], f[1]); o.y = pk2(f[2], f[3]); o.z = pk2(f[4], f[5]); o.w = pk2(f[6], f[7]);
        *(LAS u32x4*)(lds + KS_OFF + kk * KS_STRIDE + c * 16) = o;
    }
#pragma unroll
    for (int i = 0; i < 4; ++i) {
        const int task = tid + 512 * i, d = task >> 5, c = task & 31;
        u32x4 w = vw[i];
        if (key_base + c * 8 < 0) w = (u32x4){0u, 0u, 0u, 0u};
        LAS u32x2* p = (LAS u32x2*)(lds + VS_OFF + d * VS_STRIDE + c * 16);
        p[0] = (u32x2){w.x, w.y}; p[1] = (u32x2){w.z, w.w};
    }
    if (qb == 127) {
#pragma unroll
        for (int i = 0; i < 4; ++i) { const int idx = tid + 512 * i, t = idx >> 4, c4 = idx & 15; const u32x2 w = pvw[i];
            *(f32x4*)(a.out + O_VP + (size_t)(t * 2 + kvh) * 64 + c4 * 4) = (f32x4){__uint_as_float(w.x << 16), __uint_as_float(w.x & 0xffff0000u), __uint_as_float(w.y << 16), __uint_as_float(w.y & 0xffff0000u)}; }
    }
    __syncthreads();
    const float sink2 = a.sinks[head] * LOG2E;
#pragma unroll 1
    for (int sb = sb0; sb < sb0 + nsb; ++sb) {
        const int qs = qb * 128 + 32 * sb, row = qs + r;
        u32x4 qn[4];
#pragma unroll
        for (int s = 0; s < 4; ++s) qn[s] = *(const u32x4*)(Z + (size_t)(qb * 128 + 32 * min(sb + 1, sb0 + nsb - 1) + r) * NZ + ZQ + head * 64 + 16 * s + 8 * h);
        u32x4 gq[2][2];
#pragma unroll
        for (int dt = 0; dt < 2; ++dt)
#pragma unroll
            for (int kp = 0; kp < 2; ++kp) gq[dt][kp] = *(const u32x4*)(Z + (size_t)row * NZ + ZGA + head * 64 + dt * 32 + 16 * kp + 8 * h);
        bf16x8 qf[4];
        float rq;
        { float ss = 0.f;
#pragma unroll
          for (int s = 0; s < 4; ++s) { float f[8]; unpack8(qw[s], f); qf[s] = __builtin_bit_cast(bf16x8, qw[s]);
#pragma unroll
              for (int j = 0; j < 8; ++j) ss += f[j] * f[j]; }
          ss += __shfl_xor(ss, 32);
          rq = (1.0f / sqrtf(ss * (1.0f / 64.0f) + EPS)) * (0.125f * LOG2E); }
        const int kt0 = sb;
        f32x16 S[5];
        bf16x8 kf[2][4];
#pragma unroll
        for (int s = 0; s < 4; ++s) kf[0][s] = *(const LAS bf16x8*)(lds + KS_OFF + (kt0 * 32 + r) * KS_STRIDE + (16 * s + 8 * h) * 2);
#pragma unroll
        for (int i = 0; i < 5; ++i) {
            if (i + 1 < 5) {
#pragma unroll
                for (int s = 0; s < 4; ++s) kf[(i + 1) & 1][s] = *(const LAS bf16x8*)(lds + KS_OFF + ((kt0 + i + 1) * 32 + r) * KS_STRIDE + (16 * s + 8 * h) * 2);
            }
            const float s_init = (qb == 0 && kt0 + i < 4) ? -1e30f : 0.f;
#pragma unroll
            for (int e = 0; e < 16; ++e) S[i][e] = s_init;
            __builtin_amdgcn_sched_barrier(0);
#pragma unroll
            for (int s = 0; s < 4; ++s) S[i] = __builtin_amdgcn_mfma_f32_32x32x16_bf16(kf[i & 1][s], qf[s], S[i], 0, 0, 0);
            __builtin_amdgcn_sched_barrier(0);
        }
#pragma unroll
        for (int e = 0; e < 16; ++e) { const int rk = (e & 3) + 8 * (e >> 2) + 4 * h;
            S[0][e] = (rk >= r) ? S[0][e] : -1e30f; S[4][e] = (rk <= r) ? S[4][e] : -1e30f; }
        float mr = -1e30f;
#pragma unroll
        for (int i = 0; i < 5; ++i)
#pragma unroll
            for (int e = 0; e < 16; ++e) mr = fmaxf(mr, S[i][e]);
        mr = fmaxf(mr, __shfl_xor(mr, 32));
        const float mx = fmaxf(mr * rq, sink2);
        float l = 0.f;
#pragma unroll
        for (int i = 0; i < 5; ++i)
#pragma unroll
            for (int e = 0; e < 16; ++e) { const float p = __builtin_amdgcn_exp2f(__builtin_fmaf(S[i][e], rq, -mx)); S[i][e] = p; l += p; }
        l += __shfl_xor(l, 32);
        l += __builtin_amdgcn_exp2f(sink2 - mx);
        f32x16 O[2];
#pragma unroll
        for (int dt = 0; dt < 2; ++dt)
#pragma unroll
            for (int e = 0; e < 16; ++e) O[dt][e] = 0.f;
        bf16x8 vfr[4][2];
#define ATT_VREAD(T, DT) do { const LAS unsigned char* vp_ = lds + VS_OFF + ((DT) * 32 + r) * VS_STRIDE + ((kt0 + ((T) >> 1)) * 32 + 16 * ((T) & 1) + 4 * h) * 2; \
            const s16x4 v0_ = *(const LAS s16x4*)vp_, v1_ = *(const LAS s16x4*)(vp_ + 16); vfr[(T) & 3][DT] = __builtin_shufflevector(v0_, v1_, 0, 1, 2, 3, 4, 5, 6, 7); } while (0)
#pragma unroll
        for (int t = 0; t < 3; ++t) { ATT_VREAD(t, 0); ATT_VREAD(t, 1); }
#pragma unroll
        for (int t = 0; t < 10; ++t) {
            const int i = t >> 1, s2 = t & 1;
            if (t + 3 < 10) { ATT_VREAD(t + 3, 0); ATT_VREAD(t + 3, 1); }
            u32x4 pw; pw.x = pk2(S[i][8 * s2 + 0], S[i][8 * s2 + 1]); pw.y = pk2(S[i][8 * s2 + 2], S[i][8 * s2 + 3]);
            pw.z = pk2(S[i][8 * s2 + 4], S[i][8 * s2 + 5]); pw.w = pk2(S[i][8 * s2 + 6], S[i][8 * s2 + 7]);
            const bf16x8 pf = __builtin_bit_cast(bf16x8, pw);
            __builtin_amdgcn_sched_barrier(0);
            O[0] = __builtin_amdgcn_mfma_f32_32x32x16_bf16(vfr[t & 3][0], pf, O[0], 0, 0, 0);
            O[1] = __builtin_amdgcn_mfma_f32_32x32x16_bf16(vfr[t & 3][1], pf, O[1], 0, 0, 0);
            __builtin_amdgcn_sched_barrier(0);
        }
#undef ATT_VREAD
        const float inv = 1.0f / l;
#pragma unroll
        for (int dt = 0; dt < 2; ++dt)
#pragma unroll
            for (int kp = 0; kp < 2; ++kp) {
                u32x2 X = (u32x2){gq[dt][kp].x, gq[dt][kp].y}, Y = (u32x2){gq[dt][kp].z, gq[dt][kp].w};
                { auto r0 = __builtin_amdgcn_permlane32_swap(X.x, Y.x, false, false); X.x = r0[0]; Y.x = r0[1];
                  auto r1 = __builtin_amdgcn_permlane32_swap(X.y, Y.y, false, false); X.y = r1[0]; Y.y = r1[1]; }
                u32x2 o[2];
#pragma unroll
                for (int q = 0; q < 2; ++q) { const int g4 = 2 * kp + q; const u32x2 g = q ? Y : X;
                    const float g0 = __uint_as_float(g.x << 16), g1 = __uint_as_float(g.x & 0xffff0000u), g2 = __uint_as_float(g.y << 16), g3 = __uint_as_float(g.y & 0xffff0000u);
                    o[q].x = pk2(O[dt][4 * g4 + 0] * inv * g0, O[dt][4 * g4 + 1] * inv * g1);
                    o[q].y = pk2(O[dt][4 * g4 + 2] * inv * g2, O[dt][4 * g4 + 3] * inv * g3); }
                { auto r0 = __builtin_amdgcn_permlane32_swap(o[0].x, o[1].x, false, false); o[0].x = r0[0]; o[1].x = r0[1];
                  auto r1 = __builtin_amdgcn_permlane32_swap(o[0].y, o[1].y, false, false); o[0].y = r1[0]; o[1].y = r1[1]; }
                *(u32x4*)(MIX + (size_t)row * DM + head * 64 + dt * 32 + 16 * kp + 8 * h) = (u32x4){o[0].x, o[0].y, o[1].x, o[1].y};
            }
#pragma unroll
        for (int s = 0; s < 4; ++s) qw[s] = qn[s];
    }
    __syncthreads();
}

constexpr int PD_OFF = 0, PD_STRIDE = 528, PW_OFF = 128 * 528, PW_STRIDE = 272;
template <int WLEN>
__device__ __forceinline__ void window_pass(const u32x4 (&u)[23], LAS unsigned char* dst  , int tok0  ) {
    float s[8];
#pragma unroll
    for (int c = 0; c < 8; ++c) s[c] = 0.f;
#pragma unroll
    for (int j = 1; j < WLEN; ++j) { float f[8]; unpack8(u[15 - j], f);
#pragma unroll
        for (int c = 0; c < 8; ++c) s[c] += f[c]; }
#pragma unroll
    for (int tl = 0; tl < 8; ++tl) {
        float f[8], fo[8]; unpack8(u[15 + tl], f); unpack8(u[15 + tl - WLEN + 1], fo);
        const int cnt = min(WLEN, tok0 + tl + 1); const float ic = (cnt == WLEN) ? (1.0f / WLEN) : 1.0f / (float)cnt;
        float d[8];
#pragma unroll
        for (int c = 0; c < 8; ++c) { s[c] += f[c]; d[c] = s[c] * ic - f[c]; s[c] -= fo[c]; }
        u32x4 o; o.x = pk2(d[0], d[1]); o.y = pk2(d[2], d[3]); o.z = pk2(d[4], d[5]); o.w = pk2(d[6], d[7]);
        *(LAS u32x4*)(dst + tl * PD_STRIDE) = o;
    }
}
struct PoolRegs { u32x4 u[23]; u32x4 gq[2][2][2]; };
__device__ __forceinline__ void pool_load(const Args& a, int tile, int gp, PoolRegs& R) {
    int tid_ = threadIdx.x; asm volatile("" : "+v"(tid_)); const int tid = tid_, lane = tid & 63, wave = __builtin_amdgcn_readfirstlane(tid >> 6), fr = lane & 15, fq = lane >> 4;
    const bf16_t* __restrict__ Z = (const bf16_t*)(a.ws + WS_Z);
    const int t0 = tile * 128, gl = wave & 1, g = gp * 2 + gl, tb = (wave >> 1) * 32;
#pragma unroll
    for (int j = 0; j < 23; ++j) { const int pos = max(t0 + tb + 8 * (lane >> 4) - 15 + j, 0); R.u[j] = *(const u32x4*)(Z + (size_t)pos * NZ + ZU + g * 128 + (lane & 15) * 8); }
#pragma unroll
    for (int q = 0; q < 2; ++q)
#pragma unroll
        for (int m = 0; m < 2; ++m)
#pragma unroll
            for (int np = 0; np < 2; ++np) R.gq[q][m][np] = *(const u32x4*)(Z + (size_t)(t0 + tb + 16 * m + fr) * NZ + ZGP + (gp * 2 + q) * 128 + 64 * (wave & 1) + 16 * (2 * np + (fq & 1)) + 8 * (fq >> 1));
}
__device__ __forceinline__ void pool_item(const Args& a, LAS unsigned char* lds, int tile, int gp, PoolRegs& R) {
    int tid_ = threadIdx.x; asm volatile("" : "+v"(tid_)); const int tid = tid_, lane = tid & 63, wave = __builtin_amdgcn_readfirstlane(tid >> 6), fr = lane & 15, fq = lane >> 4;
    const bf16_t* __restrict__ WPT = (const bf16_t*)(a.ws + WS_WPT); bf16_t* __restrict__ MIX = (bf16_t*)(a.ws + WS_MIX);
    const int t0 = tile * 128;
    u32x4 ww[8];
#pragma unroll
    for (int i = 0; i < 8; ++i) { const int task = tid + 512 * i, rr = task >> 4, c = task & 15; ww[i] = *(const u32x4*)(WPT + (size_t)(gp * 2) * 16384 + rr * 128 + c * 8); }
    const int gl = wave & 1, g = gp * 2 + gl, tb = (wave >> 1) * 32;
    u32x4 (&u)[23] = R.u;
    const int sub = lane >> 4;
    if (tile == 0) {
#pragma unroll
        for (int j = 0; j < 15; ++j) if (tb + 8 * sub - 15 + j < 0) u[j] = (u32x4){0u, 0u, 0u, 0u};
    }
    const int row = t0 + wave * 16 + fr;
#pragma unroll
    for (int i = 0; i < 8; ++i) { const int task = tid + 512 * i, rr = task >> 4, c = task & 15; *(LAS u32x4*)(lds + PW_OFF + rr * PW_STRIDE + c * 16) = ww[i]; }
    { LAS unsigned char* dst = lds + PD_OFF + (tb + 8 * sub) * PD_STRIDE + gl * 256 + (lane & 15) * 16; const int tok0 = (tile == 0) ? tb + 8 * sub : 1000000;
      if (g == 0) window_pass<2>(u, dst, tok0); else if (g == 1) window_pass<4>(u, dst, tok0); else if (g == 2) window_pass<8>(u, dst, tok0); else window_pass<16>(u, dst, tok0); }
    if (tile == 127 && tb == 96 && sub >= 2) {
#pragma unroll
        for (int tl = 0; tl < 8; ++tl) { const int i = 96 + 8 * sub + tl - 113;
            if (i >= 0) { float f[8]; unpack8(u[15 + tl], f); float* o = a.out + O_PP + (size_t)i * 512 + g * 128 + (lane & 15) * 8;
                *(f32x4*)o = (f32x4){f[0], f[1], f[2], f[3]}; *(f32x4*)(o + 4) = (f32x4){f[4], f[5], f[6], f[7]}; } }
    }
    __syncthreads();
    f32x4 acc[2][8];
#pragma unroll
    for (int q = 0; q < 2; ++q)
#pragma unroll
        for (int n = 0; n < 8; ++n) acc[q][n] = (f32x4){0.f, 0.f, 0.f, 0.f};
    const int ddh = wave & 1;
    bf16x8 fa[2][2], fb[2][4];
#define POOL_FRAGS(T) do { const int q_ = (T) >> 2, kk_ = (T) & 3; \
        _Pragma("unroll") for (int m = 0; m < 2; ++m) fa[(T) & 1][m] = *(const LAS bf16x8*)(lds + PD_OFF + (tb + 16 * m + fr) * PD_STRIDE + q_ * 256 + (32 * kk_ + 8 * fq) * 2); \
        _Pragma("unroll") for (int n = 0; n < 4; ++n) fb[(T) & 1][n] = *(const LAS bf16x8*)(lds + PW_OFF + (q_ * 128 + 64 * ddh + 16 * n + fr) * PW_STRIDE + (32 * kk_ + 8 * fq) * 2); } while (0)
    POOL_FRAGS(0);
#pragma unroll
    for (int t = 0; t < 8; ++t) {
        if (t + 1 < 8) POOL_FRAGS(t + 1);
        __builtin_amdgcn_sched_barrier(0);
#pragma unroll
        for (int n = 0; n < 4; ++n)
#pragma unroll
            for (int m = 0; m < 2; ++m) acc[t >> 2][4 * m + n] = __builtin_amdgcn_mfma_f32_16x16x32_bf16(fb[t & 1][n], fa[t & 1][m], acc[t >> 2][4 * m + n], 0, 0, 0);
        __builtin_amdgcn_sched_barrier(0);
    }
#undef POOL_FRAGS
#pragma unroll
    for (int q = 0; q < 2; ++q)
#pragma unroll
        for (int m = 0; m < 2; ++m)
#pragma unroll
            for (int np = 0; np < 2; ++np) {
                const u32x4 gq = R.gq[q][m][np];
                u32x2 X = (u32x2){gq.x, gq.y}, Y = (u32x2){gq.z, gq.w};
                { auto r0 = __builtin_amdgcn_permlane16_swap(X.x, Y.x, false, false); X.x = r0[0]; Y.x = r0[1];
                  auto r1 = __builtin_amdgcn_permlane16_swap(X.y, Y.y, false, false); X.y = r1[0]; Y.y = r1[1]; }
                u32x2 o[2];
#pragma unroll
                for (int e = 0; e < 2; ++e) { const u32x2 gv = e ? Y : X; const f32x4 y = acc[q][4 * m + 2 * np + e];
                    const float g0 = __uint_as_float(gv.x << 16), g1 = __uint_as_float(gv.x & 0xffff0000u), g2 = __uint_as_float(gv.y << 16), g3 = __uint_as_float(gv.y & 0xffff0000u);
                    o[e].x = pk2(y.x * g0, y.y * g1); o[e].y = pk2(y.z * g2, y.w * g3); }
                { auto r0 = __builtin_amdgcn_permlane16_swap(o[0].x, o[1].x, false, false); o[0].x = r0[0]; o[1].x = r0[1];
                  auto r1 = __builtin_amdgcn_permlane16_swap(o[0].y, o[1].y, false, false); o[0].y = r1[0]; o[1].y = r1[1]; }
                *(u32x4*)(MIX + (size_t)(t0 + tb + 16 * m + fr) * DM + 512 + (gp * 2 + q) * 128 + 64 * ddh + 16 * (2 * np + (fq & 1)) + 8 * (fq >> 1)) = (u32x4){o[0].x, o[0].y, o[1].x, o[1].y};
            }
    __syncthreads();
}

struct SampleRegs { f32x4 kv[4], vv[4]; float spv[15]; float un, newv; };
__device__ __forceinline__ void sample_load(const Args& a, int b, int half, SampleRegs& R) {
    int tid_ = threadIdx.x; asm volatile("" : "+v"(tid_)); const int tid = tid_, lane = tid & 63, wave = __builtin_amdgcn_readfirstlane(tid >> 6);
    const bf16_t* __restrict__ Z = (const bf16_t*)(a.ws + WS_Z); const bf16_t* zrow = Z + (size_t)(SEQ + b) * NZ; const int kvh = half;
#pragma unroll
    for (int i = 0; i < 4; ++i) { const int idx = tid + 512 * i, key = idx >> 4, c4 = idx & 15; const size_t src = ((size_t)(b * 128 + key) * 2 + kvh) * 64 + c4 * 4;
        R.kv[i] = __builtin_nontemporal_load((const f32x4*)(a.ck + src)); R.vv[i] = __builtin_nontemporal_load((const f32x4*)(a.cv + src)); }
    const int pt = tid & 255, pgl = pt >> 7, pc = pt & 127, pg = half * 2 + pgl, pch = pg * 128 + pc;
    R.un = 0.f;
#pragma unroll
    for (int i = 0; i < 15; ++i) R.spv[i] = 0.f;
    if (tid >= 256) {
#pragma unroll
        for (int i = 0; i < 15; ++i) R.spv[i] = __builtin_nontemporal_load(a.sp + ((size_t)b * 15 + i) * 512 + pch);
        R.un = bf2f(zrow[ZU + pch]);
    }
    R.newv = 0.f;
    if (wave == 0) R.newv = bf2f(zrow[ZK + kvh * 64 + lane]); else if (wave == 1) R.newv = bf2f(zrow[ZV + kvh * 64 + lane]); else if (wave < 6) R.newv = bf2f(zrow[ZQ + (kvh * 4 + wave - 2) * 64 + lane]);
}
__device__ __forceinline__ void sample_item(const Args& a, LAS unsigned char* lds, int b, int half, const SampleRegs& R) {
    int tid_ = threadIdx.x; asm volatile("" : "+v"(tid_)); const int tid = tid_, lane = tid & 63, wave = __builtin_amdgcn_readfirstlane(tid >> 6), fr = lane & 15, fq = lane >> 4;
    const bf16_t* __restrict__ Z = (const bf16_t*)(a.ws + WS_Z); const bf16_t* __restrict__ WPT = (const bf16_t*)(a.ws + WS_WPT); bf16_t* __restrict__ MIX = (bf16_t*)(a.ws + WS_MIX);
    const bf16_t* zrow = Z + (size_t)(SEQ + b) * NZ; bf16_t* mrow = MIX + (size_t)(SEQ + b) * DM;
    LAS float* Kc = (LAS float*)lds;
    LAS float* Vc = Kc + 129 * 65 + 3;
    LAS float* qs = Vc + 129 * 64;
    LAS bf16_t* dvb = (LAS bf16_t*)(qs + 256);
    const int kvh = half;
    const int pt = tid & 255, pgl = pt >> 7, pc = pt & 127, pg = half * 2 + pgl, pch = pg * 128 + pc;
    const f32x4 (&kv)[4] = R.kv; const f32x4 (&vv)[4] = R.vv; const float (&spv)[15] = R.spv; const float un = R.un, newv = R.newv;
    bf16x8 wfr[4][4];
    if (wave >= 4) {
#pragma unroll
        for (int t = 0; t < 4; ++t) { const int nt = (wave - 4) * 4 + t, q = nt >> 3, n = nt & 7;
#pragma unroll
            for (int kk = 0; kk < 4; ++kk) wfr[t][kk] = *(const bf16x8*)(WPT + (size_t)(half * 2 + q) * 16384 + (16 * n + fr) * 128 + 32 * kk + 8 * fq); }
    }
#pragma unroll
    for (int i = 0; i < 4; ++i) { const int idx = tid + 512 * i, key = idx >> 4, c4 = idx & 15;
        LAS float* kd = Kc + key * 65 + c4 * 4; kd[0] = kv[i].x; kd[1] = kv[i].y; kd[2] = kv[i].z; kd[3] = kv[i].w;
        *(LAS f32x4*)(Vc + key * 64 + c4 * 4) = vv[i];
        if (key >= 1) { const size_t dst = ((size_t)(b * 128 + key - 1) * 2 + kvh) * 64 + c4 * 4; __builtin_nontemporal_store(kv[i], (f32x4*)(a.out + O_KS + dst)); __builtin_nontemporal_store(vv[i], (f32x4*)(a.out + O_VS + dst)); } }
    if (wave == 0) { const float ss = wave_sum(newv * newv); const float kn = newv * (1.0f / sqrtf(ss * (1.0f / 64.0f) + EPS)) * a.knw[lane];
        Kc[128 * 65 + lane] = kn; a.out[O_KS + ((size_t)(b * 128 + 127) * 2 + kvh) * 64 + lane] = kn; }
    else if (wave == 1) { Vc[128 * 64 + lane] = newv; a.out[O_VS + ((size_t)(b * 128 + 127) * 2 + kvh) * 64 + lane] = newv; }
    else if (wave < 6) { const float ss = wave_sum(newv * newv); qs[(wave - 2) * 64 + lane] = newv * (1.0f / sqrtf(ss * (1.0f / 64.0f) + EPS)) * a.qnw[lane] * 0.125f; }
    if (tid >= 256) { const int wlen = 2 << pg; float s = un; float* po = a.out + O_PS + (size_t)b * 15 * 512 + pch;
#pragma unroll
        for (int i = 0; i < 15; ++i) { if (i >= 16 - wlen) s += spv[i]; if (i >= 1) __builtin_nontemporal_store(spv[i], po + (size_t)(i - 1) * 512); }
        po[(size_t)14 * 512] = un;
        dvb[pgl * 128 + pc] = (bf16_t)(pk2(s / (float)wlen - un, 0.f) & 0xffffu); }
    __syncthreads();
    if (wave < 4) { const int hl = wave; const float sink = a.sinks[kvh * 4 + hl];
        const int col = (kvh * 4 + hl) * 64 + lane; const float ga = bf2f(zrow[ZGA + col]);
        float s0 = 0.f, s1 = 0.f, s2 = 0.f;
#pragma unroll 16
        for (int d = 0; d < 64; ++d) { const float q = qs[hl * 64 + d]; s0 += q * Kc[lane * 65 + d]; s1 += q * Kc[(lane + 64) * 65 + d]; s2 += q * Kc[128 * 65 + d]; }
        const float m = fmaxf(fmaxf(wave_max(fmaxf(s0, s1)), s2), sink);
        const float p0 = __expf(s0 - m), p1 = __expf(s1 - m), p2 = __expf(s2 - m);
        const float inv = 1.0f / (wave_sum(p0 + p1) + p2 + __expf(sink - m));
        float o = p2 * Vc[128 * 64 + lane];
#pragma unroll
        for (int key = 0; key < 64; ++key) { o += __uint_as_float(__builtin_amdgcn_readlane(__float_as_uint(p0), key)) * Vc[key * 64 + lane]; o += __uint_as_float(__builtin_amdgcn_readlane(__float_as_uint(p1), key)) * Vc[(key + 64) * 64 + lane]; }
        mrow[col] = (bf16_t)(pk2(o * inv * ga, 0.f) & 0xffffu); }
    else {
        f32x4 acc[4];
#pragma unroll
        for (int t = 0; t < 4; ++t) acc[t] = (f32x4){0.f, 0.f, 0.f, 0.f};
#pragma unroll
        for (int t = 0; t < 4; ++t) { const int nt = (wave - 4) * 4 + t, q = nt >> 3;
#pragma unroll
            for (int kk = 0; kk < 4; ++kk) { bf16x8 af = *(const LAS bf16x8*)(dvb + q * 128 + 32 * kk + 8 * fq);
                if (fr != 0) af = (bf16x8){0, 0, 0, 0, 0, 0, 0, 0};
                acc[t] = __builtin_amdgcn_mfma_f32_16x16x32_bf16(wfr[t][kk], af, acc[t], 0, 0, 0); } }
        if (fr == 0) {
#pragma unroll
            for (int t = 0; t < 4; ++t) { const int nt = (wave - 4) * 4 + t, q = nt >> 3, n = nt & 7, col = (half * 2 + q) * 128 + 16 * n + 4 * fq;
                const u32x2 gv = *(const u32x2*)(zrow + ZGP + col);
                const float g0 = __uint_as_float(gv.x << 16), g1 = __uint_as_float(gv.x & 0xffff0000u), g2 = __uint_as_float(gv.y << 16), g3 = __uint_as_float(gv.y & 0xffff0000u);
                u32x2 o; o.x = pk2(acc[t].x * g0, acc[t].y * g1); o.y = pk2(acc[t].z * g2, acc[t].w * g3);
                *(u32x2*)(mrow + 512 + col) = o; } }
    }
    __syncthreads();
}

__device__ __forceinline__ void sample_out_piece(const Args& a, LAS unsigned char* lds, int piece) {
    int tid_ = threadIdx.x; asm volatile("" : "+v"(tid_)); const int tid = tid_, lane = tid & 63, wave = __builtin_amdgcn_readfirstlane(tid >> 6), fr = lane & 15, fq = lane >> 4;
    const bf16_t* MIX = (const bf16_t*)(a.ws + WS_MIX); const bf16_t* WOUTT = (const bf16_t*)(a.ws + WS_WOUTT);
    const int pr = piece >> 5, pc = piece & 31;
    f32x4 acc[2] = {(f32x4){0.f, 0.f, 0.f, 0.f}, (f32x4){0.f, 0.f, 0.f, 0.f}};
#pragma unroll
    for (int kk = 0; kk < 4; ++kk) { const int k = wave * 128 + kk * 32 + fq * 8;
        const bf16x8 af = *(const bf16x8*)(MIX + (size_t)(SEQ + pr * 16 + fr) * DM + k);
#pragma unroll
        for (int n = 0; n < 2; ++n) { const bf16x8 bfr = *(const bf16x8*)(WOUTT + (size_t)(pc * 32 + n * 16 + fr) * DM + k);
            acc[n] = __builtin_amdgcn_mfma_f32_16x16x32_bf16(bfr, af, acc[n], 0, 0, 0); } }
    LAS f32x4* red = (LAS f32x4*)lds;
    red[(wave * 2 + 0) * 64 + lane] = acc[0]; red[(wave * 2 + 1) * 64 + lane] = acc[1];
    __syncthreads();
    if (tid < 128) { const int n = tid >> 6; f32x4 s = (f32x4){0.f, 0.f, 0.f, 0.f};
#pragma unroll
        for (int w = 0; w < 8; ++w) s += red[(w * 2 + n) * 64 + lane];
        const size_t off = (size_t)(pr * 16 + fr) * DM + pc * 32 + n * 16 + 4 * fq;
        *(f32x4*)(a.out + O_YS + off) = *(const f32x4*)(a.xs + off) + s; }
    __syncthreads();
}

__device__ __forceinline__ void preload_x(const float* __restrict__ xp, int pm, int pn, pg8::f32x4 (&acc)[2][2][4][2]) {
    if (pm < 0) return;
    const int t = threadIdx.x, wid = t >> 6, lane = t & 63, wr = wid >> 2, wc = wid & 3, fr = lane & 15, fq = lane >> 4;
    const int row0 = pm * 256 + wr * 64 + fr, col0 = pn * 256 + wc * 32 + 4 * fq;
#pragma unroll
    for (int ai = 0; ai < 2; ++ai)
#pragma unroll
        for (int m = 0; m < 4; ++m) { const size_t off = (size_t)(row0 + ai * 128 + m * 16) * DM + col0;
#pragma unroll
            for (int bj = 0; bj < 2; ++bj)
#pragma unroll
                for (int n = 0; n < 2; ++n) acc[ai][bj][m][n] = __builtin_nontemporal_load((const pg8::f32x4*)(xp + off + bj * 128 + n * 16)); }
}
struct Order1 {
    static constexpr int NUNITS = 65 * 9;
    int G, c; unsigned* cnt; int s_pm, s_pn; unsigned xcc, nloc;
    __device__ __forceinline__ bool next(int i, pg8::Unit& u) const {
        const int L = i * G + c; if (L >= NUNITS) return false;
        if (L < 512) { pg8::StaticOrder T; T.init(64 * 256, 8 * 256, 512, L); T.next(0, u);
            if (L >= 256) u.pn = 4 + ((u.pn - 4 + 2) & 3);
            return true; }
        const int j = L - 512; if (j < 64) { u.pm = j; u.pn = 8; } else { u.pm = 64; u.pn = j - 64; }
        return true;
    }
    __device__ __forceinline__ void init(int G_, int c_, unsigned* cnt_, unsigned xcc_, unsigned nloc_) { G = G_; c = c_; cnt = cnt_; xcc = xcc_; nloc = nloc_; s_pm = -1; s_pn = -1; pg8::Unit u; if (next(1, u)) { s_pm = u.pm; s_pn = u.pn; } }
    __device__ __forceinline__ void a_ready(const pg8::Unit&) const {}
    __device__ __forceinline__ void done(const pg8::Unit& u) const {
        if (cnt != nullptr && u.pm == s_pm && u.pn == s_pn) {
            asm volatile("s_waitcnt vmcnt(0)" ::: "memory");
            if ((threadIdx.x & 63) == 0) {
                const unsigned old = __hip_atomic_fetch_add(cnt + 64 * xcc, 1u, __ATOMIC_RELAXED, __HIP_MEMORY_SCOPE_AGENT);
                if (old + 1u == 8u * nloc) {
                    __builtin_amdgcn_fence(__ATOMIC_RELEASE, "agent");
                    asm volatile("s_waitcnt vmcnt(0)" ::: "memory");
                    __hip_atomic_fetch_add(cnt + 64 * 16, 1u, __ATOMIC_RELAXED, __HIP_MEMORY_SCOPE_AGENT);
                }
            }
        }
    }
};

template <int PH>
__global__ void __launch_bounds__(512, 2) mk_fwd(Args a) {
    extern __shared__ __attribute__((aligned(16))) unsigned char lds_raw[];
    LAS unsigned char* lds = (LAS unsigned char*)lds_raw;
    const int G = gridDim.x;
    const bool early = (G == 256);
    unsigned* const early_cnt = (unsigned*)(a.ws + WS_BAR) + XCD_BAR_WORDS;
    XcdBarrier bar; bar.bar = (unsigned*)(a.ws + WS_BAR); bar.x = 0; bar.st = nullptr;
    if (PH < 0) {
        if (threadIdx.x < 16) ((LAS unsigned*)(lds + LDS_CTL))[threadIdx.x] = 0u;
        __syncthreads();
        bar = xcd_barrier_post((unsigned*)(a.ws + WS_BAR), (volatile LAS unsigned*)(lds + LDS_CTL));
    }
    if (PH < 0 || PH == 0) { p0_prologue(a, lds); }
    if (PH < 0) { xcd_barrier(bar); }
    if (PH < 0 || PH == 1) {
        pg8::Gemm g{(const pg8::bf16_t*)(a.ws + WS_XB), (const pg8::bf16_t*)(a.ws + WS_WINT), MP, NZ, DM};
        Order1 S; S.init(G, (int)blockIdx.x, (PH < 0 && early) ? early_cnt : nullptr, bar.x, (PH < 0) ? bar.st[0] : 1u);
        pg8::EpiZ E{(pg8::bf16_t*)(a.ws + WS_Z), NZ, (const float*)(a.ws + WS_RSTD), (pg8::bf16_t*)(a.ws + WS_VT), MP};
        pg8::f32x4 acc[2][2][4][2];
        pg8::gemm_phase<pg8::EpiZ, Order1, true, true, false>(lds, g, S, E, acc);
        {
            const int nwg = Order1::NUNITS, rounds = (nwg + G - 1) / G, busy = nwg - (rounds - 1) * G;
            if (PH < 0 && early) {
                if ((int)blockIdx.x >= busy) {
                    if (threadIdx.x == 0) { unsigned sp = 0u; while (xb_ld(early_cnt + 64 * 16) < bar.st[1]) { __builtin_amdgcn_s_sleep(2); if (++sp > (1u << 22)) break; }
                        __builtin_amdgcn_fence(__ATOMIC_ACQUIRE, "agent"); asm volatile("s_waitcnt vmcnt(0)" ::: "memory"); }
                    __syncthreads();
                    const int j = (int)blockIdx.x - busy, nidle = G - busy;
                    if (j < 256) attn_item(a, lds, j >> 1, j & 1, 2);
                    for (int hj = j; hj < 2 * (256 - nidle); hj += nidle) { const int it = nidle + (hj >> 1); attn_item(a, lds, it >> 1, it & 1, hj & 1); }
                }
            }
        }
    }
    if (PH < 0) { xcd_barrier(bar); }
    if (PH < 0 || PH == 2) {
        for (int it = blockIdx.x; it < 256; it += G) {
            if (!(PH < 0 && early)) attn_item(a, lds, it >> 1, it & 1, 2);
            SampleRegs R; sample_load(a, it >> 1, it & 1, R);
            sample_item(a, lds, it >> 1, it & 1, R);
            PoolRegs PR; pool_load(a, it >> 1, it & 1, PR);
            pool_item(a, lds, it >> 1, it & 1, PR);
        }
    }
    pg8::f32x4 acc3[2][2][4][2];
    pg8::Unit u3; u3.pm = -1; u3.pn = -1;
    if (PH < 0) {
        pg8::StaticOrder S3; S3.init(SEQ, DM, G, (int)blockIdx.x); const bool has3 = S3.next(0, u3); if (!has3) { u3.pm = -1; u3.pn = -1; }
        asm volatile("s_waitcnt vmcnt(0)" ::: "memory");
        __syncthreads();
        if (threadIdx.x >= 64) preload_x(a.xp, u3.pm, u3.pn, acc3);
        if (threadIdx.x == 0) xcd_barrier_protocol(bar);
        if (threadIdx.x < 64) preload_x(a.xp, u3.pm, u3.pn, acc3);
        __syncthreads();
    }
    if (PH < 0 || PH == 3) {
        pg8::Gemm g{(const pg8::bf16_t*)(a.ws + WS_MIX), (const pg8::bf16_t*)(a.ws + WS_WOUTT), SEQ, DM, DM};
        pg8::StaticOrder S; S.init(SEQ, DM, G, (int)blockIdx.x);
        pg8::EpiRes E{a.xp, a.out + O_YP, DM, u3.pm, u3.pn};
        pg8::gemm_phase<pg8::EpiRes, pg8::StaticOrder, true, true, (PH < 0)>(lds, g, S, E, acc3);
        __syncthreads();
        for (int piece = blockIdx.x; piece < 256; piece += G) sample_out_piece(a, lds, piece);
    }
}

extern "C" void kernel_launch(void* const* d_in, const int* in_sizes, int n_in, void* d_out, int out_size, void* d_ws, size_t ws_size, hipStream_t stream) {
    static int grid = 0;
    if (grid == 0) {
        if (n_in != 13 || (size_t)out_size != O_END || ws_size < WS_END) { fprintf(stderr, "kernel_launch: unexpected shapes (n_in %d out %d ws %zu)\n", n_in, out_size, ws_size); grid = -1; return; }
        int dev = 0, cus = 0, per_cu = 0;
        hipGetDevice(&dev); hipDeviceGetAttribute(&cus, hipDeviceAttributeMultiprocessorCount, dev);
#if ONE_LAUNCH
        hipFuncSetAttribute((const void*)mk_fwd<-1>, hipFuncAttributeMaxDynamicSharedMemorySize, LDS_BYTES);
        hipOccupancyMaxActiveBlocksPerMultiprocessor(&per_cu, (const void*)mk_fwd<-1>, 512, LDS_BYTES);
#else
        hipFuncSetAttribute((const void*)mk_fwd<0>, hipFuncAttributeMaxDynamicSharedMemorySize, LDS_BYTES);
        hipFuncSetAttribute((const void*)mk_fwd<1>, hipFuncAttributeMaxDynamicSharedMemorySize, LDS_BYTES);
        hipFuncSetAttribute((const void*)mk_fwd<2>, hipFuncAttributeMaxDynamicSharedMemorySize, LDS_BYTES);
        hipFuncSetAttribute((const void*)mk_fwd<3>, hipFuncAttributeMaxDynamicSharedMemorySize, LDS_BYTES);
        per_cu = 1;
#endif
        if (per_cu < 1 || cus < 1) { fprintf(stderr, "kernel_launch: occupancy query gives %d blocks/CU on %d CUs\n", per_cu, cus); grid = -1; return; }
        grid = cus;
    }
    if (grid < 0) return;
    Args a{};
    a.xp = (const float*)d_in[0]; a.xs = (const float*)d_in[1]; a.ck = (const float*)d_in[2]; a.cv = (const float*)d_in[3]; a.sp = (const float*)d_in[4];
    a.normw = (const float*)d_in[5]; a.win = (const float*)d_in[6]; a.qnw = (const float*)d_in[7]; a.knw = (const float*)d_in[8]; a.sinks = (const float*)d_in[9];
    a.wpool = (const float*)d_in[10]; a.pscale = (const float*)d_in[11]; a.wout = (const float*)d_in[12];
    a.out = (float*)d_out; a.ws = (unsigned char*)d_ws;
#if ONE_LAUNCH
    hipMemsetAsync((char*)d_ws + WS_BAR, 0, (size_t)BAR_WORDS * 4, stream);
    void* args[] = {&a};
    hipError_t e = hipLaunchCooperativeKernel((const void*)mk_fwd<-1>, dim3(grid), dim3(512), args, LDS_BYTES, stream);
    if (e != hipSuccess) fprintf(stderr, "cooperative launch failed: %s (grid %d)\n", hipGetErrorString(e), grid);
#else
    hipLaunchKernelGGL(mk_fwd<0>, dim3(grid), dim3(512), LDS_BYTES, stream, a);
    hipLaunchKernelGGL(mk_fwd<1>, dim3(grid), dim3(512), LDS_BYTES, stream, a);
    hipLaunchKernelGGL(mk_fwd<2>, dim3(grid), dim3(512), LDS_BYTES, stream, a);
    hipLaunchKernelGGL(mk_fwd<3>, dim3(grid), dim3(512), LDS_BYTES, stream, a);
#endif
}
```

```cpp
#include <hip/hip_runtime.h>
#include <cstdio>
#include <cstdint>
#ifndef ONE_LAUNCH
#define ONE_LAUNCH 1
#endif
namespace pg8 {
#define PG8_LAS __attribute__((address_space(3)))
typedef unsigned short bf16_t;
typedef short bf16x8 __attribute__((ext_vector_type(8)));
typedef float f32x4 __attribute__((ext_vector_type(4)));
typedef unsigned u32x4 __attribute__((ext_vector_type(4)));
constexpr int BM = 256, BK = 64, HALF = 128, HTB = HALF * BK * 2  , STAGE_BYTES = 8 * HTB, NXCD = 8, WGM = 8;

__host__ __device__ __forceinline__ int lds_byte(int r, int c) { const int st = (r >> 4) * 2 + (c >> 5), rr = r & 15, cc = c & 31, ob = rr * 64 + cc * 2; return st * 1024 + (ob ^ (((ob >> 9) & 1) << 5)); }
__host__ __device__ __forceinline__ void stage_rc(int b, int& R, int& C) { const int st = b / 1024, sb = b % 1024, swz = sb ^ (((sb >> 9) & 1) << 5); R = (st >> 1) * 16 + swz / 64; C = (st & 1) * 32 + (swz % 64) / 2; }
__host__ __device__ __forceinline__ int perm32(int rho) { const int n = rho >> 4, i = rho & 15; return 8 * (i >> 2) + 4 * n + (i & 3); }

struct Unit { int pm, pn; };
struct Gemm { const bf16_t* A; const bf16_t* Bt; int M, N, K; };

struct StaticOrder {
    int nM, nN, nwg, G, c;
    __host__ __device__ void init(int M, int N, int G_, int c_) { nM = M / BM; nN = N / BM; nwg = nM * nN; G = G_; c = c_; }
    __host__ __device__ bool next(int i, Unit& u) const {
        const long L = (long)i * G + c; if (L >= nwg) return false;
        int wgid = (int)L; { const int q = nwg / NXCD, r = nwg % NXCD, xcd = wgid % NXCD, off = wgid / NXCD; wgid = (xcd < r ? xcd * (q + 1) : r * (q + 1) + (xcd - r) * q) + off; }
        const int nig = WGM * nN, gid = wgid / nig, fm = gid * WGM, gsz = (nM - fm) < WGM ? (nM - fm) : WGM;
        u.pm = fm + ((wgid % nig) % gsz); u.pn = (wgid % nig) / gsz; return true;
    }
    __device__ __forceinline__ void a_ready(const Unit&) const {}
    __device__ __forceinline__ void done(const Unit&) const {}
};

__device__ __forceinline__ unsigned cvt_pk_bf16(float lo, float hi) { unsigned r; asm volatile("v_cvt_pk_bf16_f32 %0, %1, %2" : "=v"(r) : "v"(lo), "v"(hi)); return r; }
struct EpiZ {
    static constexpr bool PERM = true, AFTER_DRAIN = false;
    bf16_t* Z; int ldc; const float* rstd; bf16_t* VT; int vt_ld;
    __device__ __forceinline__ void operator()(const f32x4 (&acc)[2][2][4][2], const Unit& u, int wr, int wc, int fr, int fq) const {
        const int row0 = u.pm * BM + wr * 64 + fr, col0 = u.pn * BM + wc * 32 + 8 * fq;
        const bool gate = (u.pn == 3) | (u.pn == 4) | (u.pn >= 7);
#pragma unroll
        for (int ai = 0; ai < 2; ++ai)
#pragma unroll
            for (int m = 0; m < 4; ++m) {
                const int row = row0 + ai * HALF + m * 16;
                bf16_t* rowp = Z + (size_t)row * ldc + col0;
#pragma unroll
                for (int bj = 0; bj < 2; ++bj) { f32x4 v0 = acc[ai][bj][m][0], v1 = acc[ai][bj][m][1];
                    if (gate) {
#pragma unroll
                        for (int j = 0; j < 4; ++j) { v0[j] = v0[j] * __builtin_amdgcn_rcpf(1.0f + __builtin_amdgcn_exp2f(v0[j] * -1.4426950408889634f)); v1[j] = v1[j] * __builtin_amdgcn_rcpf(1.0f + __builtin_amdgcn_exp2f(v1[j] * -1.4426950408889634f)); } }
                    u32x4 w; w.x = cvt_pk_bf16(v0[0], v0[1]); w.y = cvt_pk_bf16(v0[2], v0[3]); w.z = cvt_pk_bf16(v1[0], v1[1]); w.w = cvt_pk_bf16(v1[2], v1[3]);
                    *(u32x4*)(rowp + bj * HALF) = w;
                    if (bj == 1 && u.pn == 2) {
                        bf16_t* vt = VT + (size_t)(wc * 32 + 8 * fq) * vt_ld + row;
                        vt[0 * (size_t)vt_ld] = (bf16_t)(w.x & 0xffffu); vt[1 * (size_t)vt_ld] = (bf16_t)(w.x >> 16);
                        vt[2 * (size_t)vt_ld] = (bf16_t)(w.y & 0xffffu); vt[3 * (size_t)vt_ld] = (bf16_t)(w.y >> 16);
                        vt[4 * (size_t)vt_ld] = (bf16_t)(w.z & 0xffffu); vt[5 * (size_t)vt_ld] = (bf16_t)(w.z >> 16);
                        vt[6 * (size_t)vt_ld] = (bf16_t)(w.w & 0xffffu); vt[7 * (size_t)vt_ld] = (bf16_t)(w.w >> 16);
                    } } }
    }
};
struct EpiRes {
    static constexpr bool PERM = false, AFTER_DRAIN = false;
    const float* base; float* out; int ldc; int pre_pm, pre_pn;
    __device__ __forceinline__ void operator()(const f32x4 (&acc)[2][2][4][2], const Unit& u, int wr, int wc, int fr, int fq) const {
        const int row0 = u.pm * BM + wr * 64 + fr, col0 = u.pn * BM + wc * 32 + 4 * fq;
        if (u.pm == pre_pm && u.pn == pre_pn) {
#pragma unroll
            for (int ai = 0; ai < 2; ++ai)
#pragma unroll
                for (int m = 0; m < 4; ++m) { const size_t off = (size_t)(row0 + ai * HALF + m * 16) * ldc + col0;
#pragma unroll
                    for (int bj = 0; bj < 2; ++bj)
#pragma unroll
                        for (int n = 0; n < 2; ++n) __builtin_nontemporal_store(acc[ai][bj][m][n], (f32x4*)(out + off + bj * HALF + n * 16)); }
            return;
        }
#pragma unroll
        for (int ai = 0; ai < 2; ++ai) {
            f32x4 xv[4][2][2];
#pragma unroll
            for (int m = 0; m < 4; ++m) { const size_t off = (size_t)(row0 + ai * HALF + m * 16) * ldc + col0;
#pragma unroll
                for (int bj = 0; bj < 2; ++bj)
#pragma unroll
                    for (int n = 0; n < 2; ++n) xv[m][bj][n] = *(const f32x4*)(base + off + bj * HALF + n * 16); }
#pragma unroll
            for (int m = 0; m < 4; ++m) { const size_t off = (size_t)(row0 + ai * HALF + m * 16) * ldc + col0;
#pragma unroll
                for (int bj = 0; bj < 2; ++bj)
#pragma unroll
                    for (int n = 0; n < 2; ++n) *(f32x4*)(out + off + bj * HALF + n * 16) = xv[m][bj][n] + acc[ai][bj][m][n]; }
        }
    }
};
template <class Epi, class Sched, bool ALIGN_EPI = false, bool SP2 = false, bool PRE = false>
__device__ __forceinline__ void gemm_phase(PG8_LAS unsigned char* lds, const Gemm g, const Sched& S, const Epi& E, f32x4 (&acc)[2][2][4][2]) {
    int tid_ = threadIdx.x; asm volatile("" : "+v"(tid_));
    const int tid = tid_, wid = __builtin_amdgcn_readfirstlane(tid >> 6), lane = tid & 63, wr = wid >> 2, wc = wid & 3, fr = lane & 15, fq = lane >> 4;
    const int K = g.K, nt = K / BK;
    unsigned voffA[2], voffB[2];
#pragma unroll
    for (int i = 0; i < 2; ++i) { int R, C; stage_rc(tid * 16 + i * 8192, R, C); const int Rb = Epi::PERM ? ((R & ~31) + perm32(R & 31)) : R;
        voffA[i] = (unsigned)(R * K + C) * 2u; voffB[i] = (unsigned)(Rb * K + C) * 2u; }
    const size_t kstep = (size_t)(BK * 2);
    const size_t hstep = (size_t)HALF * K * 2;
    const size_t tstep = 2 * hstep;
    const unsigned ldsw = (unsigned)wid * 1024u;
    const int aoff = lds_byte(wr * 64 + fr, fq * 8), boff = lds_byte(wc * 32 + fr, fq * 8);
#define PG8_SA(b, h) (((b) * 2 + (h)) * HTB)
#define PG8_SB(b, h) ((4 + (b) * 2 + (h)) * HTB)
#define PG8_STAGE(bufoff, gbase, voff) do { _Pragma("unroll") for (int _i = 0; _i < 2; ++_i) \
        __builtin_amdgcn_global_load_lds((const unsigned*)((const char*)(gbase) + (voff)[_i]), (PG8_LAS unsigned*)(lds + (bufoff) + ldsw + _i * 8192), 16, 0, 0); } while (0)
#define PG8_LDA(dst, b, h) do { _Pragma("unroll") for (int m = 0; m < 4; ++m) _Pragma("unroll") for (int k = 0; k < 2; ++k) dst[m][k] = *(const PG8_LAS bf16x8*)(lds + PG8_SA(b, h) + aoff + m * 2048 + k * 1024); } while (0)
#define PG8_LDB(dst, b, h) do { _Pragma("unroll") for (int n = 0; n < 2; ++n) _Pragma("unroll") for (int k = 0; k < 2; ++k) dst[n][k] = *(const PG8_LAS bf16x8*)(lds + PG8_SB(b, h) + boff + n * 2048 + k * 1024); } while (0)
#define PG8_MMA(ai, bj, At, Bt) do { __builtin_amdgcn_s_setprio(1); _Pragma("unroll") for (int m = 0; m < 4; ++m) _Pragma("unroll") for (int n = 0; n < 2; ++n) _Pragma("unroll") for (int k = 0; k < 2; ++k) \
        acc[ai][bj][m][n] = __builtin_amdgcn_mfma_f32_16x16x32_bf16(Bt[n][k], At[m][k], acc[ai][bj][m][n], 0, 0, 0); __builtin_amdgcn_s_setprio(0); } while (0)
#define PG8_WAIT_V(n) asm volatile("s_waitcnt vmcnt(" #n ")" ::: "memory")
#define PG8_WAIT_L(n) asm volatile("s_waitcnt lgkmcnt(" #n ")" ::: "memory")
#define PG8_BAR __builtin_amdgcn_s_barrier()
#define PG8_SCHED __builtin_amdgcn_sched_barrier(0)
    Unit cur, nxt; int ui = 0;
    if (!S.next(0, cur)) return;
#pragma unroll
    for (int a = 0; a < 2; ++a)
#pragma unroll
        for (int b = 0; b < 2; ++b)
#pragma unroll
            for (int m = 0; m < 4; ++m)
#pragma unroll
                for (int n = 0; n < 2; ++n) { if constexpr (PRE) asm volatile("" : "+v"(acc[a][b][m][n]));
                                              else acc[a][b][m][n] = (f32x4){0.f, 0.f, 0.f, 0.f}; }
    bf16x8 At[4][2], B0[2][2], B1[2][2];
    const char* cA = (const char*)g.A + (size_t)cur.pm * tstep; const char* cB = (const char*)g.Bt + (size_t)cur.pn * tstep;
    S.a_ready(cur);
    if constexpr (SP2) {
        PG8_STAGE(PG8_SB(0, 0), cB, voffB); PG8_STAGE(PG8_SB(0, 1), cB + hstep, voffB); PG8_STAGE(PG8_SA(0, 0), cA, voffA); PG8_STAGE(PG8_SA(0, 1), cA + hstep, voffA);
        if (wr == 1) PG8_BAR;
        PG8_WAIT_V(2); PG8_BAR;
        PG8_STAGE(PG8_SB(1, 0), cB + kstep, voffB); PG8_STAGE(PG8_SA(1, 0), cA + kstep, voffA); PG8_STAGE(PG8_SB(1, 1), cB + hstep + kstep, voffB);
        PG8_WAIT_V(6); PG8_BAR;
    } else {
        PG8_STAGE(PG8_SB(0, 0), cB, voffB); PG8_STAGE(PG8_SA(0, 0), cA, voffA); PG8_STAGE(PG8_SB(0, 1), cB + hstep, voffB); PG8_STAGE(PG8_SA(0, 1), cA + hstep, voffA);
        if (wr == 1) PG8_BAR;
        PG8_WAIT_V(4); PG8_BAR;
        PG8_STAGE(PG8_SB(1, 0), cB + kstep, voffB); PG8_STAGE(PG8_SA(1, 0), cA + kstep, voffA); PG8_STAGE(PG8_SB(1, 1), cB + hstep + kstep, voffB);
        PG8_WAIT_V(6); PG8_BAR;
    }
    for (;;) {
        const bool has_next = S.next(ui + 1, nxt);
        const char* nA = has_next ? (const char*)g.A + (size_t)nxt.pm * tstep : cA; const char* nB = has_next ? (const char*)g.Bt + (size_t)nxt.pn * tstep : cB;
        for (int t = 0; t < nt; t += 2) {
            const bool last = (t == nt - 2);
            const char* a1 = cA + (size_t)(t + 1) * kstep;
            const char* a2 = last ? nA : cA + (size_t)(t + 2) * kstep; const char* b2 = last ? nB : cB + (size_t)(t + 2) * kstep;
            const char* a3 = a2 + kstep; const char* b3 = b2 + kstep;
            if (last && has_next) S.a_ready(nxt);
            if constexpr (SP2) {
            PG8_LDB(B0, 0, 0); PG8_LDB(B1, 0, 1); PG8_SCHED; PG8_LDA(At, 0, 0); PG8_STAGE(PG8_SA(1, 1), a1 + hstep, voffA);
            PG8_WAIT_V(8); PG8_WAIT_L(0); PG8_BAR; PG8_MMA(0, 0, At, B0); PG8_MMA(0, 1, At, B1); PG8_BAR; PG8_SCHED;
            PG8_LDA(At, 0, 1); PG8_STAGE(PG8_SB(0, 0), b2, voffB); PG8_STAGE(PG8_SB(0, 1), b2 + hstep, voffB); PG8_STAGE(PG8_SA(0, 0), a2, voffA);
            PG8_WAIT_V(8); PG8_WAIT_L(0); PG8_BAR; PG8_MMA(1, 0, At, B0); PG8_MMA(1, 1, At, B1); PG8_BAR; PG8_SCHED;
            PG8_LDB(B0, 1, 0); PG8_LDB(B1, 1, 1); PG8_SCHED; PG8_LDA(At, 1, 0); PG8_STAGE(PG8_SA(0, 1), a2 + hstep, voffA);
            PG8_WAIT_V(8); PG8_WAIT_L(0); PG8_BAR; PG8_MMA(0, 0, At, B0); PG8_MMA(0, 1, At, B1); PG8_BAR; PG8_SCHED;
            PG8_LDA(At, 1, 1); PG8_STAGE(PG8_SB(1, 0), b3, voffB); PG8_STAGE(PG8_SB(1, 1), b3 + hstep, voffB); PG8_STAGE(PG8_SA(1, 0), a3, voffA);
            PG8_WAIT_V(8); PG8_WAIT_L(0); PG8_BAR; PG8_MMA(1, 0, At, B0); PG8_MMA(1, 1, At, B1); PG8_BAR; PG8_SCHED;
            } else {
            PG8_LDB(B0, 0, 0); PG8_SCHED; PG8_LDA(At, 0, 0); PG8_STAGE(PG8_SA(1, 1), a1 + hstep, voffA);
            PG8_WAIT_L(8); PG8_BAR; PG8_WAIT_L(0); PG8_MMA(0, 0, At, B0); PG8_BAR; PG8_SCHED;
            PG8_LDB(B1, 0, 1); PG8_STAGE(PG8_SB(0, 0), b2, voffB);
            PG8_BAR; PG8_WAIT_L(0); PG8_MMA(0, 1, At, B1); PG8_BAR;
            PG8_LDA(At, 0, 1); PG8_STAGE(PG8_SA(0, 0), a2, voffA);
            PG8_BAR; PG8_WAIT_L(0); PG8_MMA(1, 0, At, B0); PG8_BAR; PG8_SCHED;
            PG8_STAGE(PG8_SB(0, 1), b2 + hstep, voffB);
            PG8_WAIT_V(6); PG8_BAR; PG8_MMA(1, 1, At, B1); PG8_BAR;
            PG8_LDB(B0, 1, 0); PG8_SCHED; PG8_LDA(At, 1, 0); PG8_STAGE(PG8_SA(0, 1), a2 + hstep, voffA);
            PG8_WAIT_L(8); PG8_BAR; PG8_WAIT_L(0); PG8_MMA(0, 0, At, B0); PG8_BAR; PG8_SCHED;
            PG8_LDB(B1, 1, 1); PG8_STAGE(PG8_SB(1, 0), b3, voffB);
            PG8_BAR; PG8_WAIT_L(0); PG8_MMA(0, 1, At, B1); PG8_BAR;
            PG8_LDA(At, 1, 1); PG8_STAGE(PG8_SA(1, 0), a3, voffA);
            PG8_BAR; PG8_WAIT_L(0); PG8_MMA(1, 0, At, B0); PG8_BAR; PG8_SCHED;
            PG8_STAGE(PG8_SB(1, 1), b3 + hstep, voffB);
            PG8_WAIT_V(6); PG8_BAR; PG8_MMA(1, 1, At, B1); PG8_BAR;
            }
        }
        if constexpr (ALIGN_EPI) { if (wr == 0) PG8_BAR; }
        if constexpr (!Epi::AFTER_DRAIN) { E(acc, cur, wr, wc, fr, fq); S.done(cur); }
        if (!has_next) break;
#pragma unroll
        for (int a = 0; a < 2; ++a)
#pragma unroll
            for (int b = 0; b < 2; ++b)
#pragma unroll
                for (int m = 0; m < 4; ++m)
#pragma unroll
                    for (int n = 0; n < 2; ++n) acc[a][b][m][n] = (f32x4){0.f, 0.f, 0.f, 0.f};
        cur = nxt; cA = nA; cB = nB; ++ui;
        if constexpr (ALIGN_EPI) { if (wr == 1) PG8_BAR; }
    }
    PG8_WAIT_V(0);
    if constexpr (!ALIGN_EPI) { if (wr == 0) PG8_BAR; }
    PG8_BAR;
    if constexpr (Epi::AFTER_DRAIN) { E.fused(acc, cur, wr, wc, fr, fq, lds, wid, lane); S.done(cur); }
#undef PG8_SA
#undef PG8_SB
#undef PG8_STAGE
#undef PG8_LDA
#undef PG8_LDB
#undef PG8_MMA
#undef PG8_WAIT_V
#undef PG8_WAIT_L
#undef PG8_BAR
#undef PG8_SCHED
}
}

#define LAS __attribute__((address_space(3)))
#define XB_TMO      128
#define XB_XCNT(j)  (256  + 64 * (j))
#define XB_XSUB(j)  (1280 + 64 * (j))
#define XB_XGEN(j)  (2304 + 64 * (j))
#define XB_TOP      3328
#define XB_TOPGEN   3392
#define XCD_BAR_WORDS 3456
#define XB_SPIN_CAP (1u << 18)

__device__ __forceinline__ unsigned xb_ld(unsigned* p)              { return __hip_atomic_load(p, __ATOMIC_RELAXED, __HIP_MEMORY_SCOPE_AGENT); }
__device__ __forceinline__ unsigned xb_add(unsigned* p, unsigned v) { return __hip_atomic_fetch_add(p, v, __ATOMIC_RELAXED, __HIP_MEMORY_SCOPE_AGENT); }
__device__ __forceinline__ unsigned xb_xcc_id() { return (unsigned)__builtin_amdgcn_s_getreg((3 << 11) | 20) & 0xFu; }
#define XB_SPIN(cond, bar) do { unsigned _sp = 0; while (cond) { __builtin_amdgcn_s_sleep(1); \
    if ((++_sp & 255u) == 0u) { if (xb_ld(&(bar)[XB_TMO])) break; if (_sp > XB_SPIN_CAP) { atomicAdd(&(bar)[XB_TMO], 1u); break; } } } } while (0)

struct XcdBarrier {
    unsigned* bar; unsigned x;
    volatile LAS unsigned* st;
};

__device__ __forceinline__ XcdBarrier xcd_barrier_post(unsigned* bar, volatile LAS unsigned* st) {
    XcdBarrier b; b.bar = bar; b.x = xb_xcc_id(); b.st = st;
    if (threadIdx.x == 0) (void)xb_add(&bar[XB_XCNT(b.x)], 1u);
    return b;
}
__device__ __forceinline__ void xcd_barrier_complete(unsigned* bar, unsigned x, unsigned& nloc, unsigned& nx) {
    const unsigned G = gridDim.x * gridDim.y * gridDim.z;
    unsigned sum, cnt, mine, sp = 0u;
    for (;;) {
        sum = 0u; cnt = 0u; mine = 0u;
#pragma unroll
        for (unsigned j = 0; j < 16; ++j) { const unsigned c = xb_ld(&bar[XB_XCNT(j)]); sum += c; cnt += (c > 0u) ? 1u : 0u; mine = (j == x) ? c : mine; }
        if (sum == G) break;
        __builtin_amdgcn_s_sleep(1);
        if ((++sp & 255u) == 0u) { if (xb_ld(&bar[XB_TMO])) break; if (sp > XB_SPIN_CAP) { atomicAdd(&bar[XB_TMO], 1u); break; } }
    }
    nloc = mine > 0u ? mine : 1u; nx = cnt > 0u ? cnt : 1u;
}

__device__ __forceinline__ void xcd_barrier_protocol(const XcdBarrier& b) {
    {
        unsigned* bar = b.bar;
        __builtin_amdgcn_s_waitcnt(0);
        unsigned nloc = b.st[0], nx = b.st[1];
        if (nloc == 0u) { xcd_barrier_complete(bar, b.x, nloc, nx); b.st[0] = nloc; b.st[1] = nx; }
        const unsigned old = xb_add(&bar[XB_XSUB(b.x)], 1u);
        const unsigned gen = old / nloc;
        if (old + 1u == (gen + 1u) * nloc) {
            __builtin_amdgcn_fence(__ATOMIC_RELEASE, "agent");
            asm volatile("s_waitcnt vmcnt(0)" ::: "memory");
            const unsigned og = xb_add(&bar[XB_TOP], 1u);
            const unsigned tg = og / nx;
            if (og + 1u == (tg + 1u) * nx) xb_add(&bar[XB_TOPGEN], 1u);
            else XB_SPIN(xb_ld(&bar[XB_TOPGEN]) == tg, bar);
            __builtin_amdgcn_fence(__ATOMIC_ACQUIRE, "agent");
            xb_add(&bar[XB_XGEN(b.x)], 1u);
            asm volatile("s_waitcnt vmcnt(0)" ::: "memory");
        } else {
            XB_SPIN(xb_ld(&bar[XB_XGEN(b.x)]) == gen, bar);
            __builtin_amdgcn_fence(__ATOMIC_ACQUIRE, "agent");
            asm volatile("s_waitcnt vmcnt(0)" ::: "memory");
        }
    }
}
__device__ __forceinline__ void xcd_barrier(const XcdBarrier& b) {
    asm volatile("s_waitcnt vmcnt(0)" ::: "memory");
    __syncthreads();
    if (threadIdx.x == 0) xcd_barrier_protocol(b);
    __syncthreads();
}

typedef unsigned short bf16_t;
typedef short bf16x8 __attribute__((ext_vector_type(8)));
typedef short s16x4 __attribute__((ext_vector_type(4)));
typedef float f32x4 __attribute__((ext_vector_type(4)));
typedef float f32x16 __attribute__((ext_vector_type(16)));
typedef unsigned u32x4 __attribute__((ext_vector_type(4)));
typedef unsigned u32x2 __attribute__((ext_vector_type(2)));

constexpr int DM = 1024, SEQ = 16384, NSMP = 128, MP = 16640  , NZ = 2304;
constexpr int ZQ = 0, ZK = 512, ZV = 640, ZGA = 768, ZU = 1280, ZGP = 1792;
constexpr float EPS = 1e-6f, LOG2E = 1.4426950408889634f;
constexpr int LDS_CTL = 139264, LDS_BYTES = LDS_CTL + 64;
constexpr size_t WS_XB = 0;
constexpr size_t WS_RSTD = WS_XB + (size_t)MP * DM * 2;
constexpr size_t WS_WINT = WS_RSTD + (size_t)MP * 4;
constexpr size_t WS_WOUTT = WS_WINT + (size_t)NZ * DM * 2;
constexpr size_t WS_WPT = WS_WOUTT + (size_t)DM * DM * 2;
constexpr size_t WS_Z = WS_WPT + (size_t)4 * 128 * 128 * 2;
constexpr size_t WS_VT = WS_Z + (size_t)MP * NZ * 2;
constexpr size_t WS_MIX = WS_VT + (size_t)128 * MP * 2;
constexpr size_t WS_BAR = WS_MIX + (size_t)MP * DM * 2;
constexpr int BAR_WORDS = XCD_BAR_WORDS + 64 * 17;
constexpr size_t WS_END = WS_BAR + (size_t)BAR_WORDS * 4;
constexpr size_t O_YP = 0, O_YS = O_YP + (size_t)SEQ * DM, O_KP = O_YS + (size_t)NSMP * DM, O_VP = O_KP + 128 * 128, O_PP = O_VP + 128 * 128,
                 O_KS = O_PP + 15 * 512, O_VS = O_KS + (size_t)NSMP * 128 * 128, O_PS = O_VS + (size_t)NSMP * 128 * 128, O_END = O_PS + (size_t)NSMP * 15 * 512;

struct Args {
    const float *xp, *xs, *ck, *cv, *sp, *normw, *win, *qnw, *knw, *sinks, *wpool, *pscale, *wout;
    float* out; unsigned char* ws;
};

__device__ __forceinline__ float bf2f(unsigned b) { return __uint_as_float(b << 16); }
__device__ __forceinline__ unsigned pk2(float lo, float hi) { unsigned r; asm volatile("v_cvt_pk_bf16_f32 %0, %1, %2" : "=v"(r) : "v"(lo), "v"(hi)); return r; }
__device__ __forceinline__ float wave_sum(float v) {
#pragma unroll
    for (int o = 32; o > 0; o >>= 1) v += __shfl_xor(v, o);
    return v;
}
__device__ __forceinline__ float wave_max(float v) {
#pragma unroll
    for (int o = 32; o > 0; o >>= 1) v = fmaxf(v, __shfl_xor(v, o));
    return v;
}
__device__ __forceinline__ float silu(float x) { return x * __builtin_amdgcn_rcpf(1.0f + __expf(-x)); }
__device__ __forceinline__ void unpack8(const u32x4 w, float (&f)[8]) {
    f[0] = __uint_as_float(w.x << 16); f[1] = __uint_as_float(w.x & 0xffff0000u); f[2] = __uint_as_float(w.y << 16); f[3] = __uint_as_float(w.y & 0xffff0000u);
    f[4] = __uint_as_float(w.z << 16); f[5] = __uint_as_float(w.z & 0xffff0000u); f[6] = __uint_as_float(w.w << 16); f[7] = __uint_as_float(w.w & 0xffff0000u);
}

struct TileDesc { const float* src; bf16_t* dst; const float* kscale; const float* nscale; int K, N, k0, n0; };
__device__ __forceinline__ TileDesc tile_desc(const Args& a, int it) {
    constexpr int I_IN = 16 * 36, I_OUT = 16 * 16;
    TileDesc t;
    if (it < I_IN) { t.src = a.win; t.dst = (bf16_t*)(a.ws + WS_WINT); t.kscale = a.normw; t.nscale = nullptr; t.K = DM; t.N = NZ; t.k0 = (it & 15) * 64; t.n0 = (it >> 4) * 64; return t; }
    it -= I_IN;
    if (it < I_OUT) { t.src = a.wout; t.dst = (bf16_t*)(a.ws + WS_WOUTT); t.kscale = nullptr; t.nscale = nullptr; t.K = DM; t.N = DM; t.k0 = (it & 15) * 64; t.n0 = (it >> 4) * 64; return t; }
    it -= I_OUT;
    { const int g = it >> 2; t.src = a.wpool + g * 16384; t.dst = (bf16_t*)(a.ws + WS_WPT) + g * 16384; t.kscale = nullptr; t.nscale = a.pscale + g * 128; t.K = 128; t.N = 128; t.k0 = ((it >> 1) & 1) * 64; t.n0 = (it & 1) * 64; }
    return t;
}
__device__ __forceinline__ void p0_prologue(const Args& a, LAS unsigned char* lds) {
    int tid_ = threadIdx.x; asm volatile("" : "+v"(tid_)); const int tid = tid_, lane = tid & 63, wave = tid >> 6;
    bf16_t* XB = (bf16_t*)(a.ws + WS_XB);
    constexpr int NITEMS = 16 * 36 + 16 * 16 + 16;
    LAS float* scr = (LAS float*)lds;
    for (int it0 = blockIdx.x; it0 < NITEMS; it0 += 4 * gridDim.x) {
        f32x4 va[4], vb[4];
#pragma unroll
        for (int j = 0; j < 4; ++j) { const int it = it0 + j * gridDim.x;
            if (it < NITEMS) { const TileDesc t = tile_desc(a, it); const int kr = tid >> 3, c = tid & 7; const float* s = t.src + (size_t)(t.k0 + kr) * t.N + t.n0 + c * 8;
                va[j] = __builtin_nontemporal_load((const f32x4*)s); vb[j] = __builtin_nontemporal_load((const f32x4*)(s + 4));
                const float sc = t.kscale ? t.kscale[t.k0 + kr] : 1.0f; va[j] *= sc; vb[j] *= sc;
                if (t.nscale) { va[j] *= *(const f32x4*)(t.nscale + t.n0 + c * 8); vb[j] *= *(const f32x4*)(t.nscale + t.n0 + c * 8 + 4); } } }
#pragma unroll
        for (int j = 0; j < 4; ++j) { const int it = it0 + j * gridDim.x;
            if (it < NITEMS) { const TileDesc t = tile_desc(a, it);
                { const int kr = tid >> 3, c = tid & 7; LAS float* d = scr + kr * 65 + c * 8;
                  d[0] = va[j].x; d[1] = va[j].y; d[2] = va[j].z; d[3] = va[j].w; d[4] = vb[j].x; d[5] = vb[j].y; d[6] = vb[j].z; d[7] = vb[j].w; }
                __syncthreads();
                { const int n = tid >> 3, kc = tid & 7; const LAS float* sp = scr + (kc * 8) * 65 + n;
                  u32x4 o; o.x = pk2(sp[0], sp[65]); o.y = pk2(sp[130], sp[195]); o.z = pk2(sp[260], sp[325]); o.w = pk2(sp[390], sp[455]);
                  *(u32x4*)(t.dst + (size_t)(t.n0 + n) * t.K + t.k0 + kc * 8) = o; }
                __syncthreads(); } }
    }
    const int gw = blockIdx.x * 8 + wave, NGW = gridDim.x * 8;
    for (int m0 = gw; m0 < MP; m0 += 2 * NGW) {
        f32x4 v[2][4];
#pragma unroll
        for (int q = 0; q < 2; ++q) { const int m = m0 + q * NGW;
            if (m < SEQ + NSMP) { const float* xr = (m < SEQ) ? a.xp + (size_t)m * DM : a.xs + (size_t)(m - SEQ) * DM; const f32x4* x4 = (const f32x4*)xr + lane;
#pragma unroll
                for (int j = 0; j < 4; ++j) v[q][j] = __builtin_nontemporal_load(x4 + 64 * j); }
            else {
#pragma unroll
                for (int j = 0; j < 4; ++j) v[q][j] = (f32x4){0.f, 0.f, 0.f, 0.f}; } }
#pragma unroll
        for (int q = 0; q < 2; ++q) { const int m = m0 + q * NGW;
            if (m < MP) { float ss = 0.f;
#pragma unroll
                for (int j = 0; j < 4; ++j) ss += (v[q][j].x * v[q][j].x + v[q][j].y * v[q][j].y) + (v[q][j].z * v[q][j].z + v[q][j].w * v[q][j].w);
                ss = wave_sum(ss);
                const float rs = 1.0f / sqrtf(ss * (1.0f / DM) + EPS);
                unsigned long long* o8 = (unsigned long long*)(XB + (size_t)m * DM) + lane;
#pragma unroll
                for (int j = 0; j < 4; ++j) o8[64 * j] = (unsigned long long)pk2(v[q][j].x * rs, v[q][j].y * rs) | ((unsigned long long)pk2(v[q][j].z * rs, v[q][j].w * rs) << 32); } }
    }
}

constexpr int KS_STRIDE = 144, VS_STRIDE = 520, KS_OFF = 0, VS_OFF = 256 * KS_STRIDE;

__device__ __forceinline__ void attn_item(const Args& a, LAS unsigned char* lds, int qb, int kvh, int hsel) {
    int tid_ = threadIdx.x; asm volatile("" : "+v"(tid_)); const int tid = tid_, lane = tid & 63, wave = __builtin_amdgcn_readfirstlane(tid >> 6);
    const bf16_t* __restrict__ Z = (const bf16_t*)(a.ws + WS_Z); const bf16_t* __restrict__ VT = (const bf16_t*)(a.ws + WS_VT); bf16_t* __restrict__ MIX = (bf16_t*)(a.ws + WS_MIX);
    const int key_base = (qb - 1) * 128;
    const int head = kvh * 4 + ((hsel == 2) ? (wave >> 1) : (2 * hsel + (wave >> 2))), sb0 = (hsel == 2) ? 2 * (wave & 1) : (wave & 3), nsb = (hsel == 2) ? 2 : 1, r = lane & 31, h = lane >> 5;
    u32x4 kw[4], vw[4], qw[4];
#pragma unroll
    for (int i = 0; i < 4; ++i) { const int task = tid + 512 * i, kk = task >> 3, c = task & 7, pos = max(key_base + kk, 0);
        kw[i] = *(const u32x4*)(Z + (size_t)pos * NZ + ZK + kvh * 64 + c * 8); }
#pragma unroll
    for (int i = 0; i < 4; ++i) { const int task = tid + 512 * i, d = task >> 5, c = task & 31, pos = max(key_base + c * 8, 0);
        vw[i] = *(const u32x4*)(VT + (size_t)(kvh * 64 + d) * MP + pos); }
#pragma unroll
    for (int s = 0; s < 4; ++s) qw[s] = *(const u32x4*)(Z + (size_t)(qb * 128 + 32 * sb0 + r) * NZ + ZQ + head * 64 + 16 * s + 8 * h);
    u32x2 pvw[4];
    if (qb == 127) {
#pragma unroll
        for (int i = 0; i < 4; ++i) { const int idx = tid + 512 * i, t = idx >> 4, c4 = idx & 15; pvw[i] = *(const u32x2*)(Z + (size_t)(SEQ - 128 + t) * NZ + ZV + kvh * 64 + c4 * 4); }
    }
    const f32x4 kn0 = *(const f32x4*)(a.knw + (tid & 7) * 8), kn1 = *(const f32x4*)(a.knw + (tid & 7) * 8 + 4);
    const f32x4 kq0 = kn0 * *(const f32x4*)(a.qnw + (tid & 7) * 8), kq1 = kn1 * *(const f32x4*)(a.qnw + (tid & 7) * 8 + 4);
#pragma unroll
    for (int i = 0; i < 4; ++i) {
        const int task = tid + 512 * i, kk = task >> 3, c = task & 7;
        float f[8];
        u32x4 w = kw[i];
        if (key_base + kk < 0) w = (u32x4){0u, 0u, 0u, 0u};
        unpack8(w, f);
        float ss = 0.f;
#pragma unroll
        for (int j = 0; j < 8; ++j) ss += f[j] * f[j];
        ss += __shfl_xor(ss, 1); ss += __shfl_xor(ss, 2); ss += __shfl_xor(ss, 4);
        const float rr = 1.0f / sqrtf(ss * (1.0f / 64.0f) + EPS);
        if (qb == 127 && kk >= 128) {
            float* o = a.out + O_KP + (size_t)((kk - 128) * 2 + kvh) * 64 + c * 8;
            *(f32x4*)o = (f32x4){f[0] * rr * kn0.x, f[1] * rr * kn0.y, f[2] * rr * kn0.z, f[3] * rr * kn0.w}; *(f32x4*)(o + 4) = (f32x4){f[4] * rr * kn1.x, f[5] * rr * kn1.y, f[6] * rr * kn1.z, f[7] * rr * kn1.w};
        }
        f[0] *= rr * kq0.x; f[1] *= rr * kq0.y; f[2] *= rr * kq0.z; f[3] *= rr * kq0.w; f[4] *= rr * kq1.x; f[5] *= rr * kq1.y; f[6] *= rr * kq1.z; f[7] *= rr * kq1.w;
        u32x4 o; o.x = pk2(f[0], f[1]); o.y = pk2(f[2], f[3]); o.z = pk2(f[4], f[5]); o.w = pk2(f[6], f[7]);
        *(LAS u32x4*)(lds + KS_OFF + kk * KS_STRIDE + c * 16) = o;
    }
#pragma unroll
    for (int i = 0; i < 4; ++i) {
        const int task = tid + 512 * i, d = task >> 5, c = task & 31;
        u32x4 w = vw[i];
        if (key_base + c * 8 < 0) w = (u32x4){0u, 0u, 0u, 0u};
        LAS u32x2* p = (LAS u32x2*)(lds + VS_OFF + d * VS_STRIDE + c * 16);
        p[0] = (u32x2){w.x, w.y}; p[1] = (u32x2){w.z, w.w};
    }
    if (qb == 127) {
#pragma unroll
        for (int i = 0; i < 4; ++i) { const int idx = tid + 512 * i, t = idx >> 4, c4 = idx & 15; const u32x2 w = pvw[i];
            *(f32x4*)(a.out + O_VP + (size_t)(t * 2 + kvh) * 64 + c4 * 4) = (f32x4){__uint_as_float(w.x << 16), __uint_as_float(w.x & 0xffff0000u), __uint_as_float(w.y << 16), __uint_as_float(w.y & 0xffff0000u)}; }
    }
    __syncthreads();
    const float sink2 = a.sinks[head] * LOG2E;
#pragma unroll 1
    for (int sb = sb0; sb < sb0 + nsb; ++sb) {
        const int qs = qb * 128 + 32 * sb, row = qs + r;
        u32x4 qn[4];
        if (sb + 1 < sb0 + nsb) {
#pragma unroll
            for (int s = 0; s < 4; ++s) qn[s] = *(const u32x4*)(Z + (size_t)(qb * 128 + 32 * (sb + 1) + r) * NZ + ZQ + head * 64 + 16 * s + 8 * h);
        } else {
#pragma unroll
            for (int s = 0; s < 4; ++s) qn[s] = (u32x4){0u, 0u, 0u, 0u};
        }
        u32x4 gq[2][2];
#pragma unroll
        for (int dt = 0; dt < 2; ++dt)
#pragma unroll
            for (int kp = 0; kp < 2; ++kp) gq[dt][kp] = *(const u32x4*)(Z + (size_t)row * NZ + ZGA + head * 64 + dt * 32 + 16 * kp + 8 * h);
        bf16x8 qf[4];
        float rq;
        { float ss = 0.f;
#pragma unroll
          for (int s = 0; s < 4; ++s) { float f[8]; unpack8(qw[s], f); qf[s] = __builtin_bit_cast(bf16x8, qw[s]);
#pragma unroll
              for (int j = 0; j < 8; ++j) ss += f[j] * f[j]; }
          ss += __shfl_xor(ss, 32);
          rq = (1.0f / sqrtf(ss * (1.0f / 64.0f) + EPS)) * (0.125f * LOG2E); }
        const int kt0 = sb;
        f32x16 S[5];
        bf16x8 kf[2][4];
#pragma unroll
        for (int s = 0; s < 4; ++s) kf[0][s] = *(const LAS bf16x8*)(lds + KS_OFF + (kt0 * 32 + r) * KS_STRIDE + (16 * s + 8 * h) * 2);
#pragma unroll
        for (int i = 0; i < 5; ++i) {
            if (i + 1 < 5) {
#pragma unroll
                for (int s = 0; s < 4; ++s) kf[(i + 1) & 1][s] = *(const LAS bf16x8*)(lds + KS_OFF + ((kt0 + i + 1) * 32 + r) * KS_STRIDE + (16 * s + 8 * h) * 2);
            }
            const float s_init = (qb == 0 && kt0 + i < 4) ? -1e30f : 0.f;
#pragma unroll
            for (int e = 0; e < 16; ++e) S[i][e] = s_init;
            __builtin_amdgcn_sched_barrier(0);
#pragma unroll
            for (int s = 0; s < 4; ++s) S[i] = __builtin_amdgcn_mfma_f32_32x32x16_bf16(kf[i & 1][s], qf[s], S[i], 0, 0, 0);
            __builtin_amdgcn_sched_barrier(0);
        }
#pragma unroll
        for (int e = 0; e < 16; ++e) { const int rk = (e & 3) + 8 * (e >> 2) + 4 * h;
            S[0][e] = (rk >= r) ? S[0][e] : -1e30f; S[4][e] = (rk <= r) ? S[4][e] : -1e30f; }
        float mr = -1e30f;
#pragma unroll
        for (int i = 0; i < 5; ++i)
#pragma unroll
            for (int e = 0; e < 16; ++e) mr = fmaxf(mr, S[i][e]);
        mr = fmaxf(mr, __shfl_xor(mr, 32));
        const float mx = fmaxf(mr * rq, sink2);
        float l = 0.f;
#pragma unroll
        for (int i = 0; i < 5; ++i)
#pragma unroll
            for (int e = 0; e < 16; ++e) { const float p = __builtin_amdgcn_exp2f(__builtin_fmaf(S[i][e], rq, -mx)); S[i][e] = p; l += p; }
        l += __shfl_xor(l, 32);
        l += __builtin_amdgcn_exp2f(sink2 - mx);
        f32x16 O[2];
#pragma unroll
        for (int dt = 0; dt < 2; ++dt)
#pragma unroll
            for (int e = 0; e < 16; ++e) O[dt][e] = 0.f;
        bf16x8 vfr[4][2];
#define ATT_VREAD(T, DT) do { const LAS unsigned char* vp_ = lds + VS_OFF + ((DT) * 32 + r) * VS_STRIDE + ((kt0 + ((T) >> 1)) * 32 + 16 * ((T) & 1) + 4 * h) * 2; \
            const s16x4 v0_ = *(const LAS s16x4*)vp_, v1_ = *(const LAS s16x4*)(vp_ + 16); vfr[(T) & 3][DT] = __builtin_shufflevector(v0_, v1_, 0, 1, 2, 3, 4, 5, 6, 7); } while (0)
#pragma unroll
        for (int t = 0; t < 3; ++t) { ATT_VREAD(t, 0); ATT_VREAD(t, 1); }
#pragma unroll
        for (int t = 0; t < 10; ++t) {
            const int i = t >> 1, s2 = t & 1;
            if (t + 3 < 10) { ATT_VREAD(t + 3, 0); ATT_VREAD(t + 3, 1); }
            u32x4 pw; pw.x = pk2(S[i][8 * s2 + 0], S[i][8 * s2 + 1]); pw.y = pk2(S[i][8 * s2 + 2], S[i][8 * s2 + 3]);
            pw.z = pk2(S[i][8 * s2 + 4], S[i][8 * s2 + 5]); pw.w = pk2(S[i][8 * s2 + 6], S[i][8 * s2 + 7]);
            const bf16x8 pf = __builtin_bit_cast(bf16x8, pw);
            __builtin_amdgcn_sched_barrier(0);
            O[0] = __builtin_amdgcn_mfma_f32_32x32x16_bf16(vfr[t & 3][0], pf, O[0], 0, 0, 0);
            O[1] = __builtin_amdgcn_mfma_f32_32x32x16_bf16(vfr[t & 3][1], pf, O[1], 0, 0, 0);
            __builtin_amdgcn_sched_barrier(0);
        }
#undef ATT_VREAD
        const float inv = 1.0f / l;
#pragma unroll
        for (int dt = 0; dt < 2; ++dt)
#pragma unroll
            for (int kp = 0; kp < 2; ++kp) {
                u32x2 X = (u32x2){gq[dt][kp].x, gq[dt][kp].y}, Y = (u32x2){gq[dt][kp].z, gq[dt][kp].w};
                { auto r0 = __builtin_amdgcn_permlane32_swap(X.x, Y.x, false, false); X.x = r0[0]; Y.x = r0[1];
                  auto r1 = __builtin_amdgcn_permlane32_swap(X.y, Y.y, false, false); X.y = r1[0]; Y.y = r1[1]; }
                u32x2 o[2];
#pragma unroll
                for (int q = 0; q < 2; ++q) { const int g4 = 2 * kp + q; const u32x2 g = q ? Y : X;
                    const float g0 = __uint_as_float(g.x << 16), g1 = __uint_as_float(g.x & 0xffff0000u), g2 = __uint_as_float(g.y << 16), g3 = __uint_as_float(g.y & 0xffff0000u);
                    o[q].x = pk2(O[dt][4 * g4 + 0] * inv * g0, O[dt][4 * g4 + 1] * inv * g1);
                    o[q].y = pk2(O[dt][4 * g4 + 2] * inv * g2, O[dt][4 * g4 + 3] * inv * g3); }
                { auto r0 = __builtin_amdgcn_permlane32_swap(o[0].x, o[1].x, false, false); o[0].x = r0[0]; o[1].x = r0[1];
                  auto r1 = __builtin_amdgcn_permlane32_swap(o[0].y, o[1].y, false, false); o[0].y = r1[0]; o[1].y = r1[1]; }
                *(u32x4*)(MIX + (size_t)row * DM + head * 64 + dt * 32 + 16 * kp + 8 * h) = (u32x4){o[0].x, o[0].y, o[1].x, o[1].y};
            }
#pragma unroll
        for (int s = 0; s < 4; ++s) qw[s] = qn[s];
    }
    __syncthreads();
}

constexpr int PD_OFF = 0, PD_STRIDE = 528, PW_OFF = 128 * 528, PW_STRIDE = 272;
template <int WLEN>
__device__ __forceinline__ void window_pass(const u32x4 (&u)[23], LAS unsigned char* dst  , int tok0  ) {
    float s[8];
#pragma unroll
    for (int c = 0; c < 8; ++c) s[c] = 0.f;
#pragma unroll
    for (int j = 1; j < WLEN; ++j) { float f[8]; unpack8(u[15 - j], f);
#pragma unroll
        for (int c = 0; c < 8; ++c) s[c] += f[c]; }
#pragma unroll
    for (int tl = 0; tl < 8; ++tl) {
        float f[8], fo[8]; unpack8(u[15 + tl], f); unpack8(u[15 + tl - WLEN + 1], fo);
        const int cnt = min(WLEN, tok0 + tl + 1); const float ic = (cnt == WLEN) ? (1.0f / WLEN) : 1.0f / (float)cnt;
        float d[8];
#pragma unroll
        for (int c = 0; c < 8; ++c) { s[c] += f[c]; d[c] = s[c] * ic - f[c]; s[c] -= fo[c]; }
        u32x4 o; o.x = pk2(d[0], d[1]); o.y = pk2(d[2], d[3]); o.z = pk2(d[4], d[5]); o.w = pk2(d[6], d[7]);
        *(LAS u32x4*)(dst + tl * PD_STRIDE) = o;
    }
}
struct PoolRegs { u32x4 u[23]; u32x4 gq[2][2][2]; };
__device__ __forceinline__ void pool_load(const Args& a, int tile, int gp, PoolRegs& R) {
    int tid_ = threadIdx.x; asm volatile("" : "+v"(tid_)); const int tid = tid_, lane = tid & 63, wave = __builtin_amdgcn_readfirstlane(tid >> 6), fr = lane & 15, fq = lane >> 4;
    const bf16_t* __restrict__ Z = (const bf16_t*)(a.ws + WS_Z);
    const int t0 = tile * 128, gl = wave & 1, g = gp * 2 + gl, tb = (wave >> 1) * 32;
#pragma unroll
    for (int j = 0; j < 23; ++j) { const int pos = max(t0 + tb + 8 * (lane >> 4) - 15 + j, 0); R.u[j] = *(const u32x4*)(Z + (size_t)pos * NZ + ZU + g * 128 + (lane & 15) * 8); }
#pragma unroll
    for (int q = 0; q < 2; ++q)
#pragma unroll
        for (int m = 0; m < 2; ++m)
#pragma unroll
            for (int np = 0; np < 2; ++np) R.gq[q][m][np] = *(const u32x4*)(Z + (size_t)(t0 + tb + 16 * m + fr) * NZ + ZGP + (gp * 2 + q) * 128 + 64 * (wave & 1) + 16 * (2 * np + (fq & 1)) + 8 * (fq >> 1));
}
__device__ __forceinline__ void pool_item(const Args& a, LAS unsigned char* lds, int tile, int gp, PoolRegs& R) {
    int tid_ = threadIdx.x; asm volatile("" : "+v"(tid_)); const int tid = tid_, lane = tid & 63, wave = __builtin_amdgcn_readfirstlane(tid >> 6), fr = lane & 15, fq = lane >> 4;
    const bf16_t* __restrict__ WPT = (const bf16_t*)(a.ws + WS_WPT); bf16_t* __restrict__ MIX = (bf16_t*)(a.ws + WS_MIX);
    const int t0 = tile * 128;
    u32x4 ww[8];
#pragma unroll
    for (int i = 0; i < 8; ++i) { const int task = tid + 512 * i, rr = task >> 4, c = task & 15; ww[i] = *(const u32x4*)(WPT + (size_t)(gp * 2) * 16384 + rr * 128 + c * 8); }
    const int gl = wave & 1, g = gp * 2 + gl, tb = (wave >> 1) * 32;
    u32x4 (&u)[23] = R.u;
    const int sub = lane >> 4;
    if (tile == 0) {
#pragma unroll
        for (int j = 0; j < 15; ++j) if (tb + 8 * sub - 15 + j < 0) u[j] = (u32x4){0u, 0u, 0u, 0u};
    }
    const int row = t0 + wave * 16 + fr;
#pragma unroll
    for (int i = 0; i < 8; ++i) { const int task = tid + 512 * i, rr = task >> 4, c = task & 15; *(LAS u32x4*)(lds + PW_OFF + rr * PW_STRIDE + c * 16) = ww[i]; }
    { LAS unsigned char* dst = lds + PD_OFF + (tb + 8 * sub) * PD_STRIDE + gl * 256 + (lane & 15) * 16; const int tok0 = (tile == 0) ? tb + 8 * sub : 1000000;
      if (g == 0) window_pass<2>(u, dst, tok0); else if (g == 1) window_pass<4>(u, dst, tok0); else if (g == 2) window_pass<8>(u, dst, tok0); else window_pass<16>(u, dst, tok0); }
    if (tile == 127 && tb == 96 && sub >= 2) {
#pragma unroll
        for (int tl = 0; tl < 8; ++tl) { const int i = 96 + 8 * sub + tl - 113;
            if (i >= 0) { float f[8]; unpack8(u[15 + tl], f); float* o = a.out + O_PP + (size_t)i * 512 + g * 128 + (lane & 15) * 8;
                *(f32x4*)o = (f32x4){f[0], f[1], f[2], f[3]}; *(f32x4*)(o + 4) = (f32x4){f[4], f[5], f[6], f[7]}; } }
    }
    __syncthreads();
    f32x4 acc[2][8];
#pragma unroll
    for (int q = 0; q < 2; ++q)
#pragma unroll
        for (int n = 0; n < 8; ++n) acc[q][n] = (f32x4){0.f, 0.f, 0.f, 0.f};
    const int ddh = wave & 1;
    bf16x8 fa[2][2], fb[2][4];
#define POOL_FRAGS(T) do { const int q_ = (T) >> 2, kk_ = (T) & 3; \
        _Pragma("unroll") for (int m = 0; m < 2; ++m) fa[(T) & 1][m] = *(const LAS bf16x8*)(lds + PD_OFF + (tb + 16 * m + fr) * PD_STRIDE + q_ * 256 + (32 * kk_ + 8 * fq) * 2); \
        _Pragma("unroll") for (int n = 0; n < 4; ++n) fb[(T) & 1][n] = *(const LAS bf16x8*)(lds + PW_OFF + (q_ * 128 + 64 * ddh + 16 * n + fr) * PW_STRIDE + (32 * kk_ + 8 * fq) * 2); } while (0)
    POOL_FRAGS(0);
#pragma unroll
    for (int t = 0; t < 8; ++t) {
        if (t + 1 < 8) POOL_FRAGS(t + 1);
        __builtin_amdgcn_sched_barrier(0);
#pragma unroll
        for (int n = 0; n < 4; ++n)
#pragma unroll
            for (int m = 0; m < 2; ++m) acc[t >> 2][4 * m + n] = __builtin_amdgcn_mfma_f32_16x16x32_bf16(fb[t & 1][n], fa[t & 1][m], acc[t >> 2][4 * m + n], 0, 0, 0);
        __builtin_amdgcn_sched_barrier(0);
    }
#undef POOL_FRAGS
#pragma unroll
    for (int q = 0; q < 2; ++q)
#pragma unroll
        for (int m = 0; m < 2; ++m)
#pragma unroll
            for (int np = 0; np < 2; ++np) {
                const u32x4 gq = R.gq[q][m][np];
                u32x2 X = (u32x2){gq.x, gq.y}, Y = (u32x2){gq.z, gq.w};
                { auto r0 = __builtin_amdgcn_permlane16_swap(X.x, Y.x, false, false); X.x = r0[0]; Y.x = r0[1];
                  auto r1 = __builtin_amdgcn_permlane16_swap(X.y, Y.y, false, false); X.y = r1[0]; Y.y = r1[1]; }
                u32x2 o[2];
#pragma unroll
                for (int e = 0; e < 2; ++e) { const u32x2 gv = e ? Y : X; const f32x4 y = acc[q][4 * m + 2 * np + e];
                    const float g0 = __uint_as_float(gv.x << 16), g1 = __uint_as_float(gv.x & 0xffff0000u), g2 = __uint_as_float(gv.y << 16), g3 = __uint_as_float(gv.y & 0xffff0000u);
                    o[e].x = pk2(y.x * g0, y.y * g1); o[e].y = pk2(y.z * g2, y.w * g3); }
                { auto r0 = __builtin_amdgcn_permlane16_swap(o[0].x, o[1].x, false, false); o[0].x = r0[0]; o[1].x = r0[1];
                  auto r1 = __builtin_amdgcn_permlane16_swap(o[0].y, o[1].y, false, false); o[0].y = r1[0]; o[1].y = r1[1]; }
                *(u32x4*)(MIX + (size_t)(t0 + tb + 16 * m + fr) * DM + 512 + (gp * 2 + q) * 128 + 64 * ddh + 16 * (2 * np + (fq & 1)) + 8 * (fq >> 1)) = (u32x4){o[0].x, o[0].y, o[1].x, o[1].y};
            }
    __syncthreads();
}

struct SampleRegs { f32x4 kv[4], vv[4]; float spv[15]; float un, newv; };
__device__ __forceinline__ void sample_load(const Args& a, int b, int half, SampleRegs& R) {
    int tid_ = threadIdx.x; asm volatile("" : "+v"(tid_)); const int tid = tid_, lane = tid & 63, wave = __builtin_amdgcn_readfirstlane(tid >> 6);
    const bf16_t* __restrict__ Z = (const bf16_t*)(a.ws + WS_Z); const bf16_t* zrow = Z + (size_t)(SEQ + b) * NZ; const int kvh = half;
#pragma unroll
    for (int i = 0; i < 4; ++i) { const int idx = tid + 512 * i, key = idx >> 4, c4 = idx & 15; const size_t src = ((size_t)(b * 128 + key) * 2 + kvh) * 64 + c4 * 4;
        R.kv[i] = __builtin_nontemporal_load((const f32x4*)(a.ck + src)); R.vv[i] = __builtin_nontemporal_load((const f32x4*)(a.cv + src)); }
    const int pt = tid & 255, pgl = pt >> 7, pc = pt & 127, pg = half * 2 + pgl, pch = pg * 128 + pc;
    R.un = 0.f;
#pragma unroll
    for (int i = 0; i < 15; ++i) R.spv[i] = 0.f;
    if (tid >= 256) {
#pragma unroll
        for (int i = 0; i < 15; ++i) R.spv[i] = __builtin_nontemporal_load(a.sp + ((size_t)b * 15 + i) * 512 + pch);
        R.un = bf2f(zrow[ZU + pch]);
    }
    R.newv = 0.f;
    if (wave == 0) R.newv = bf2f(zrow[ZK + kvh * 64 + lane]); else if (wave == 1) R.newv = bf2f(zrow[ZV + kvh * 64 + lane]); else if (wave < 6) R.newv = bf2f(zrow[ZQ + (kvh * 4 + wave - 2) * 64 + lane]);
}
__device__ __forceinline__ void sample_item(const Args& a, LAS unsigned char* lds, int b, int half, const SampleRegs& R) {
    int tid_ = threadIdx.x; asm volatile("" : "+v"(tid_)); const int tid = tid_, lane = tid & 63, wave = __builtin_amdgcn_readfirstlane(tid >> 6), fr = lane & 15, fq = lane >> 4;
    const bf16_t* __restrict__ Z = (const bf16_t*)(a.ws + WS_Z); const bf16_t* __restrict__ WPT = (const bf16_t*)(a.ws + WS_WPT); bf16_t* __restrict__ MIX = (bf16_t*)(a.ws + WS_MIX);
    const bf16_t* zrow = Z + (size_t)(SEQ + b) * NZ; bf16_t* mrow = MIX + (size_t)(SEQ + b) * DM;
    LAS float* Kc = (LAS float*)lds;
    LAS float* Vc = Kc + 129 * 65 + 3;
    LAS float* qs = Vc + 129 * 64;
    LAS bf16_t* dvb = (LAS bf16_t*)(qs + 256);
    const int kvh = half;
    const int pt = tid & 255, pgl = pt >> 7, pc = pt & 127, pg = half * 2 + pgl, pch = pg * 128 + pc;
    const f32x4 (&kv)[4] = R.kv; const f32x4 (&vv)[4] = R.vv; const float (&spv)[15] = R.spv; const float un = R.un, newv = R.newv;
    bf16x8 wfr[4][4];
    if (wave >= 4) {
#pragma unroll
        for (int t = 0; t < 4; ++t) { const int nt = (wave - 4) * 4 + t, q = nt >> 3, n = nt & 7;
#pragma unroll
            for (int kk = 0; kk < 4; ++kk) wfr[t][kk] = *(const bf16x8*)(WPT + (size_t)(half * 2 + q) * 16384 + (16 * n + fr) * 128 + 32 * kk + 8 * fq); }
    }
#pragma unroll
    for (int i = 0; i < 4; ++i) { const int idx = tid + 512 * i, key = idx >> 4, c4 = idx & 15;
        LAS float* kd = Kc + key * 65 + c4 * 4; kd[0] = kv[i].x; kd[1] = kv[i].y; kd[2] = kv[i].z; kd[3] = kv[i].w;
        *(LAS f32x4*)(Vc + key * 64 + c4 * 4) = vv[i];
        if (key >= 1) { const size_t dst = ((size_t)(b * 128 + key - 1) * 2 + kvh) * 64 + c4 * 4; __builtin_nontemporal_store(kv[i], (f32x4*)(a.out + O_KS + dst)); __builtin_nontemporal_store(vv[i], (f32x4*)(a.out + O_VS + dst)); } }
    if (wave == 0) { const float ss = wave_sum(newv * newv); const float kn = newv * (1.0f / sqrtf(ss * (1.0f / 64.0f) + EPS)) * a.knw[lane];
        Kc[128 * 65 + lane] = kn; a.out[O_KS + ((size_t)(b * 128 + 127) * 2 + kvh) * 64 + lane] = kn; }
    else if (wave == 1) { Vc[128 * 64 + lane] = newv; a.out[O_VS + ((size_t)(b * 128 + 127) * 2 + kvh) * 64 + lane] = newv; }
    else if (wave < 6) { const float ss = wave_sum(newv * newv); qs[(wave - 2) * 64 + lane] = newv * (1.0f / sqrtf(ss * (1.0f / 64.0f) + EPS)) * a.qnw[lane] * 0.125f; }
    if (tid >= 256) { const int wlen = 2 << pg; float s = un; float* po = a.out + O_PS + (size_t)b * 15 * 512 + pch;
#pragma unroll
        for (int i = 0; i < 15; ++i) { if (i >= 16 - wlen) s += spv[i]; if (i >= 1) __builtin_nontemporal_store(spv[i], po + (size_t)(i - 1) * 512); }
        po[(size_t)14 * 512] = un;
        dvb[pgl * 128 + pc] = (bf16_t)(pk2(s / (float)wlen - un, 0.f) & 0xffffu); }
    __syncthreads();
    if (wave < 4) { const int hl = wave; const float sink = a.sinks[kvh * 4 + hl];
        const int col = (kvh * 4 + hl) * 64 + lane; const float ga = bf2f(zrow[ZGA + col]);
        float s0 = 0.f, s1 = 0.f, s2 = 0.f;
#pragma unroll 16
        for (int d = 0; d < 64; ++d) { const float q = qs[hl * 64 + d]; s0 += q * Kc[lane * 65 + d]; s1 += q * Kc[(lane + 64) * 65 + d]; s2 += q * Kc[128 * 65 + d]; }
        const float m = fmaxf(fmaxf(wave_max(fmaxf(s0, s1)), s2), sink);
        const float p0 = __expf(s0 - m), p1 = __expf(s1 - m), p2 = __expf(s2 - m);
        const float inv = 1.0f / (wave_sum(p0 + p1) + p2 + __expf(sink - m));
        float o = p2 * Vc[128 * 64 + lane];
#pragma unroll
        for (int key = 0; key < 64; ++key) { o += __uint_as_float(__builtin_amdgcn_readlane(__float_as_uint(p0), key)) * Vc[key * 64 + lane]; o += __uint_as_float(__builtin_amdgcn_readlane(__float_as_uint(p1), key)) * Vc[(key + 64) * 64 + lane]; }
        mrow[col] = (bf16_t)(pk2(o * inv * ga, 0.f) & 0xffffu); }
    else {
        f32x4 acc[4];
#pragma unroll
        for (int t = 0; t < 4; ++t) acc[t] = (f32x4){0.f, 0.f, 0.f, 0.f};
#pragma unroll
        for (int t = 0; t < 4; ++t) { const int nt = (wave - 4) * 4 + t, q = nt >> 3;
#pragma unroll
            for (int kk = 0; kk < 4; ++kk) { bf16x8 af = *(const LAS bf16x8*)(dvb + q * 128 + 32 * kk + 8 * fq);
                if (fr != 0) af = (bf16x8){0, 0, 0, 0, 0, 0, 0, 0};
                acc[t] = __builtin_amdgcn_mfma_f32_16x16x32_bf16(wfr[t][kk], af, acc[t], 0, 0, 0); } }
        if (fr == 0) {
#pragma unroll
            for (int t = 0; t < 4; ++t) { const int nt = (wave - 4) * 4 + t, q = nt >> 3, n = nt & 7, col = (half * 2 + q) * 128 + 16 * n + 4 * fq;
                const u32x2 gv = *(const u32x2*)(zrow + ZGP + col);
                const float g0 = __uint_as_float(gv.x << 16), g1 = __uint_as_float(gv.x & 0xffff0000u), g2 = __uint_as_float(gv.y << 16), g3 = __uint_as_float(gv.y & 0xffff0000u);
                u32x2 o; o.x = pk2(acc[t].x * g0, acc[t].y * g1); o.y = pk2(acc[t].z * g2, acc[t].w * g3);
                *(u32x2*)(mrow + 512 + col) = o; } }
    }
    __syncthreads();
}

__device__ __forceinline__ void sample_out_piece(const Args& a, LAS unsigned char* lds, int piece) {
    int tid_ = threadIdx.x; asm volatile("" : "+v"(tid_)); const int tid = tid_, lane = tid & 63, wave = __builtin_amdgcn_readfirstlane(tid >> 6), fr = lane & 15, fq = lane >> 4;
    const bf16_t* MIX = (const bf16_t*)(a.ws + WS_MIX); const bf16_t* WOUTT = (const bf16_t*)(a.ws + WS_WOUTT);
    const int pr = piece >> 5, pc = piece & 31;
    f32x4 acc[2] = {(f32x4){0.f, 0.f, 0.f, 0.f}, (f32x4){0.f, 0.f, 0.f, 0.f}};
#pragma unroll
    for (int kk = 0; kk < 4; ++kk) { const int k = wave * 128 + kk * 32 + fq * 8;
        const bf16x8 af = *(const bf16x8*)(MIX + (size_t)(SEQ + pr * 16 + fr) * DM + k);
#pragma unroll
        for (int n = 0; n < 2; ++n) { const bf16x8 bfr = *(const bf16x8*)(WOUTT + (size_t)(pc * 32 + n * 16 + fr) * DM + k);
            acc[n] = __builtin_amdgcn_mfma_f32_16x16x32_bf16(bfr, af, acc[n], 0, 0, 0); } }
    LAS f32x4* red = (LAS f32x4*)lds;
    red[(wave * 2 + 0) * 64 + lane] = acc[0]; red[(wave * 2 + 1) * 64 + lane] = acc[1];
    __syncthreads();
    if (tid < 128) { const int n = tid >> 6; f32x4 s = (f32x4){0.f, 0.f, 0.f, 0.f};
#pragma unroll
        for (int w = 0; w < 8; ++w) s += red[(w * 2 + n) * 64 + lane];
        const size_t off = (size_t)(pr * 16 + fr) * DM + pc * 32 + n * 16 + 4 * fq;
        *(f32x4*)(a.out + O_YS + off) = *(const f32x4*)(a.xs + off) + s; }
    __syncthreads();
}

__device__ __forceinline__ void preload_x(const float* __restrict__ xp, int pm, int pn, pg8::f32x4 (&acc)[2][2][4][2]) {
    if (pm < 0) return;
    const int t = threadIdx.x, wid = t >> 6, lane = t & 63, wr = wid >> 2, wc = wid & 3, fr = lane & 15, fq = lane >> 4;
    const int row0 = pm * 256 + wr * 64 + fr, col0 = pn * 256 + wc * 32 + 4 * fq;
#pragma unroll
    for (int ai = 0; ai < 2; ++ai)
#pragma unroll
        for (int m = 0; m < 4; ++m) { const size_t off = (size_t)(row0 + ai * 128 + m * 16) * DM + col0;
#pragma unroll
            for (int bj = 0; bj < 2; ++bj)
#pragma unroll
                for (int n = 0; n < 2; ++n) acc[ai][bj][m][n] = __builtin_nontemporal_load((const pg8::f32x4*)(xp + off + bj * 128 + n * 16)); }
}
struct Order1 {
    static constexpr int NUNITS = 65 * 9;
    int G, c; unsigned* cnt; int s_pm, s_pn; unsigned xcc, nloc;
    __device__ __forceinline__ bool next(int i, pg8::Unit& u) const {
        const int L = i * G + c; if (L >= NUNITS) return false;
        if (L < 512) { pg8::StaticOrder T; T.init(64 * 256, 8 * 256, 512, L); T.next(0, u);
            if (L >= 256) u.pn = 4 + ((u.pn - 4 + 2) & 3);
            return true; }
        const int j = L - 512; if (j < 64) { u.pm = j; u.pn = 8; } else { u.pm = 64; u.pn = j - 64; }
        return true;
    }
    __device__ __forceinline__ void init(int G_, int c_, unsigned* cnt_, unsigned xcc_, unsigned nloc_) { G = G_; c = c_; cnt = cnt_; xcc = xcc_; nloc = nloc_; s_pm = -1; s_pn = -1; pg8::Unit u; if (next(1, u)) { s_pm = u.pm; s_pn = u.pn; } }
    __device__ __forceinline__ void a_ready(const pg8::Unit&) const {}
    __device__ __forceinline__ void done(const pg8::Unit& u) const {
        if (cnt != nullptr && u.pm == s_pm && u.pn == s_pn) {
            asm volatile("s_waitcnt vmcnt(0)" ::: "memory");
            if ((threadIdx.x & 63) == 0) {
                const unsigned old = __hip_atomic_fetch_add(cnt + 64 * xcc, 1u, __ATOMIC_RELAXED, __HIP_MEMORY_SCOPE_AGENT);
                if (old + 1u == 8u * nloc) {
                    __builtin_amdgcn_fence(__ATOMIC_RELEASE, "agent");
                    asm volatile("s_waitcnt vmcnt(0)" ::: "memory");
                    __hip_atomic_fetch_add(cnt + 64 * 16, 1u, __ATOMIC_RELAXED, __HIP_MEMORY_SCOPE_AGENT);
                }
            }
        }
    }
};

template <int PH>
__global__ void __launch_bounds__(512, 2) mk_fwd(Args a) {
    extern __shared__ __attribute__((aligned(16))) unsigned char lds_raw[];
    LAS unsigned char* lds = (LAS unsigned char*)lds_raw;
    const int G = gridDim.x;
    const bool early = (G == 256);
    unsigned* const early_cnt = (unsigned*)(a.ws + WS_BAR) + XCD_BAR_WORDS;
    XcdBarrier bar; bar.bar = (unsigned*)(a.ws + WS_BAR); bar.x = 0; bar.st = nullptr;
    if (PH < 0) {
        if (threadIdx.x < 16) ((LAS unsigned*)(lds + LDS_CTL))[threadIdx.x] = 0u;
        __syncthreads();
        bar = xcd_barrier_post((unsigned*)(a.ws + WS_BAR), (volatile LAS unsigned*)(lds + LDS_CTL));
    }
    if (PH < 0 || PH == 0) { p0_prologue(a, lds); }
    if (PH < 0) { xcd_barrier(bar); }
    if (PH < 0 || PH == 1) {
        pg8::Gemm g{(const pg8::bf16_t*)(a.ws + WS_XB), (const pg8::bf16_t*)(a.ws + WS_WINT), MP, NZ, DM};
        Order1 S; S.init(G, (int)blockIdx.x, (PH < 0 && early) ? early_cnt : nullptr, bar.x, (PH < 0) ? bar.st[0] : 1u);
        pg8::EpiZ E{(pg8::bf16_t*)(a.ws + WS_Z), NZ, (const float*)(a.ws + WS_RSTD), (pg8::bf16_t*)(a.ws + WS_VT), MP};
        pg8::f32x4 acc[2][2][4][2];
        pg8::gemm_phase<pg8::EpiZ, Order1, true, true, false>(lds, g, S, E, acc);
        {
            const int nwg = Order1::NUNITS, rounds = (nwg + G - 1) / G, busy = nwg - (rounds - 1) * G;
            if (PH < 0 && early) {
                if ((int)blockIdx.x >= busy) {
                    if (threadIdx.x == 0) { unsigned sp = 0u; while (xb_ld(early_cnt + 64 * 16) < bar.st[1]) { __builtin_amdgcn_s_sleep(2); if (++sp > (1u << 22)) break; }
                        __builtin_amdgcn_fence(__ATOMIC_ACQUIRE, "agent"); asm volatile("s_waitcnt vmcnt(0)" ::: "memory"); }
                    __syncthreads();
                    const int j = (int)blockIdx.x - busy, nidle = G - busy;
                    if (j < 256) attn_item(a, lds, j >> 1, j & 1, 2);
                    for (int hj = j; hj < 2 * (256 - nidle); hj += nidle) { const int it = nidle + (hj >> 1); attn_item(a, lds, it >> 1, it & 1, hj & 1); }
                }
            }
        }
    }
    if (PH < 0) { xcd_barrier(bar); }
    if (PH < 0 || PH == 2) {
        for (int it = blockIdx.x; it < 256; it += G) {
            if (!(PH < 0 && early)) attn_item(a, lds, it >> 1, it & 1, 2);
            SampleRegs R; sample_load(a, it >> 1, it & 1, R);
            sample_item(a, lds, it >> 1, it & 1, R);
            PoolRegs PR; pool_load(a, it >> 1, it & 1, PR);
            pool_item(a, lds, it >> 1, it & 1, PR);
        }
    }
    pg8::f32x4 acc3[2][2][4][2];
    pg8::Unit u3; u3.pm = -1; u3.pn = -1;
    if (PH < 0) {
        pg8::StaticOrder S3; S3.init(SEQ, DM, G, (int)blockIdx.x); const bool has3 = S3.next(0, u3); if (!has3) { u3.pm = -1; u3.pn = -1; }
        asm volatile("s_waitcnt vmcnt(0)" ::: "memory");
        __syncthreads();
        if (threadIdx.x >= 64) preload_x(a.xp, u3.pm, u3.pn, acc3);
        if (threadIdx.x == 0) xcd_barrier_protocol(bar);
        if (threadIdx.x < 64) preload_x(a.xp, u3.pm, u3.pn, acc3);
        __syncthreads();
    }
    if (PH < 0 || PH == 3) {
        pg8::Gemm g{(const pg8::bf16_t*)(a.ws + WS_MIX), (const pg8::bf16_t*)(a.ws + WS_WOUTT), SEQ, DM, DM};
        pg8::StaticOrder S; S.init(SEQ, DM, G, (int)blockIdx.x);
        pg8::EpiRes E{a.xp, a.out + O_YP, DM, u3.pm, u3.pn};
        pg8::gemm_phase<pg8::EpiRes, pg8::StaticOrder, true, true, (PH < 0)>(lds, g, S, E, acc3);
        __syncthreads();
        for (int piece = blockIdx.x; piece < 256; piece += G) sample_out_piece(a, lds, piece);
    }
}

extern "C" void kernel_launch(void* const* d_in, const int* in_sizes, int n_in, void* d_out, int out_size, void* d_ws, size_t ws_size, hipStream_t stream) {
    static int grid = 0;
    if (grid == 0) {
        if (n_in != 13 || (size_t)out_size != O_END || ws_size < WS_END) { fprintf(stderr, "kernel_launch: unexpected shapes (n_in %d out %d ws %zu)\n", n_in, out_size, ws_size); grid = -1; return; }
        int dev = 0, cus = 0, per_cu = 0;
        hipGetDevice(&dev); hipDeviceGetAttribute(&cus, hipDeviceAttributeMultiprocessorCount, dev);
#if ONE_LAUNCH
        hipFuncSetAttribute((const void*)mk_fwd<-1>, hipFuncAttributeMaxDynamicSharedMemorySize, LDS_BYTES);
        hipOccupancyMaxActiveBlocksPerMultiprocessor(&per_cu, (const void*)mk_fwd<-1>, 512, LDS_BYTES);
#else
        hipFuncSetAttribute((const void*)mk_fwd<0>, hipFuncAttributeMaxDynamicSharedMemorySize, LDS_BYTES);
        hipFuncSetAttribute((const void*)mk_fwd<1>, hipFuncAttributeMaxDynamicSharedMemorySize, LDS_BYTES);
        hipFuncSetAttribute((const void*)mk_fwd<2>, hipFuncAttributeMaxDynamicSharedMemorySize, LDS_BYTES);
        hipFuncSetAttribute((const void*)mk_fwd<3>, hipFuncAttributeMaxDynamicSharedMemorySize, LDS_BYTES);
        per_cu = 1;
#endif
        if (per_cu < 1 || cus < 1) { fprintf(stderr, "kernel_launch: occupancy query gives %d blocks/CU on %d CUs\n", per_cu, cus); grid = -1; return; }
        grid = cus;
    }
    if (grid < 0) return;
    Args a{};
    a.xp = (const float*)d_in[0]; a.xs = (const float*)d_in[1]; a.ck = (const float*)d_in[2]; a.cv = (const float*)d_in[3]; a.sp = (const float*)d_in[4];
    a.normw = (const float*)d_in[5]; a.win = (const float*)d_in[6]; a.qnw = (const float*)d_in[7]; a.knw = (const float*)d_in[8]; a.sinks = (const float*)d_in[9];
    a.wpool = (const float*)d_in[10]; a.pscale = (const float*)d_in[11]; a.wout = (const float*)d_in[12];
    a.out = (float*)d_out; a.ws = (unsigned char*)d_ws;
#if ONE_LAUNCH
    hipMemsetAsync((char*)d_ws + WS_BAR, 0, (size_t)BAR_WORDS * 4, stream);
    void* args[] = {&a};
    hipError_t e = hipLaunchCooperativeKernel((const void*)mk_fwd<-1>, dim3(grid), dim3(512), args, LDS_BYTES, stream);
    if (e != hipSuccess) fprintf(stderr, "cooperative launch failed: %s (grid %d)\n", hipGetErrorString(e), grid);
#else
    hipLaunchKernelGGL(mk_fwd<0>, dim3(grid), dim3(512), LDS_BYTES, stream, a);
    hipLaunchKernelGGL(mk_fwd<1>, dim3(grid), dim3(512), LDS_BYTES, stream, a);
    hipLaunchKernelGGL(mk_fwd<2>, dim3(grid), dim3(512), LDS_BYTES, stream, a);
    hipLaunchKernelGGL(mk_fwd<3>, dim3(grid), dim3(512), LDS_BYTES, stream, a);
#endif
}
```

```cpp
#include <hip/hip_runtime.h>
#include <cstdio>
#include <cstdint>
#ifndef ONE_LAUNCH
#define ONE_LAUNCH 1
#endif
namespace pg8 {
#define PG8_LAS __attribute__((address_space(3)))
typedef unsigned short bf16_t;
typedef short bf16x8 __attribute__((ext_vector_type(8)));
typedef float f32x4 __attribute__((ext_vector_type(4)));
typedef unsigned u32x4 __attribute__((ext_vector_type(4)));
constexpr int BM = 256, BK = 64, HALF = 128, HTB = HALF * BK * 2  , STAGE_BYTES = 8 * HTB, NXCD = 8, WGM = 8;

__host__ __device__ __forceinline__ int lds_byte(int r, int c) { const int st = (r >> 4) * 2 + (c >> 5), rr = r & 15, cc = c & 31, ob = rr * 64 + cc * 2; return st * 1024 + (ob ^ (((ob >> 9) & 1) << 5)); }
__host__ __device__ __forceinline__ void stage_rc(int b, int& R, int& C) { const int st = b / 1024, sb = b % 1024, swz = sb ^ (((sb >> 9) & 1) << 5); R = (st >> 1) * 16 + swz / 64; C = (st & 1) * 32 + (swz % 64) / 2; }
__host__ __device__ __forceinline__ int perm32(int rho) { const int n = rho >> 4, i = rho & 15; return 8 * (i >> 2) + 4 * n + (i & 3); }

struct Unit { int pm, pn; };
struct Gemm { const bf16_t* A; const bf16_t* Bt; int M, N, K; };

struct StaticOrder {
    int nM, nN, nwg, G, c;
    __host__ __device__ void init(int M, int N, int G_, int c_) { nM = M / BM; nN = N / BM; nwg = nM * nN; G = G_; c = c_; }
    __host__ __device__ bool next(int i, Unit& u) const {
        const long L = (long)i * G + c; if (L >= nwg) return false;
        int wgid = (int)L; { const int q = nwg / NXCD, r = nwg % NXCD, xcd = wgid % NXCD, off = wgid / NXCD; wgid = (xcd < r ? xcd * (q + 1) : r * (q + 1) + (xcd - r) * q) + off; }
        const int nig = WGM * nN, gid = wgid / nig, fm = gid * WGM, gsz = (nM - fm) < WGM ? (nM - fm) : WGM;
        u.pm = fm + ((wgid % nig) % gsz); u.pn = (wgid % nig) / gsz; return true;
    }
    __device__ __forceinline__ void a_ready(const Unit&) const {}
    __device__ __forceinline__ void done(const Unit&) const {}
};

__device__ __forceinline__ unsigned cvt_pk_bf16(float lo, float hi) { unsigned r; asm volatile("v_cvt_pk_bf16_f32 %0, %1, %2" : "=v"(r) : "v"(lo), "v"(hi)); return r; }
struct EpiZ {
    static constexpr bool PERM = true, AFTER_DRAIN = false;
    bf16_t* Z; int ldc; const float* rstd; bf16_t* VT; int vt_ld;
    __device__ __forceinline__ void operator()(const f32x4 (&acc)[2][2][4][2], const Unit& u, int wr, int wc, int fr, int fq) const {
        const int row0 = u.pm * BM + wr * 64 + fr, col0 = u.pn * BM + wc * 32 + 8 * fq;
        const bool gate = (u.pn == 3) | (u.pn == 4) | (u.pn >= 7);
#pragma unroll
        for (int ai = 0; ai < 2; ++ai)
#pragma unroll
            for (int m = 0; m < 4; ++m) {
                const int row = row0 + ai * HALF + m * 16;
                bf16_t* rowp = Z + (size_t)row * ldc + col0;
#pragma unroll
                for (int bj = 0; bj < 2; ++bj) { f32x4 v0 = acc[ai][bj][m][0], v1 = acc[ai][bj][m][1];
                    if (gate) {
#pragma unroll
                        for (int j = 0; j < 4; ++j) { v0[j] = v0[j] * __builtin_amdgcn_rcpf(1.0f + __builtin_amdgcn_exp2f(v0[j] * -1.4426950408889634f)); v1[j] = v1[j] * __builtin_amdgcn_rcpf(1.0f + __builtin_amdgcn_exp2f(v1[j] * -1.4426950408889634f)); } }
                    u32x4 w; w.x = cvt_pk_bf16(v0[0], v0[1]); w.y = cvt_pk_bf16(v0[2], v0[3]); w.z = cvt_pk_bf16(v1[0], v1[1]); w.w = cvt_pk_bf16(v1[2], v1[3]);
                    *(u32x4*)(rowp + bj * HALF) = w;
                    if (bj == 1 && u.pn == 2) {
                        bf16_t* vt = VT + (size_t)(wc * 32 + 8 * fq) * vt_ld + row;
                        vt[0 * (size_t)vt_ld] = (bf16_t)(w.x & 0xffffu); vt[1 * (size_t)vt_ld] = (bf16_t)(w.x >> 16);
                        vt[2 * (size_t)vt_ld] = (bf16_t)(w.y & 0xffffu); vt[3 * (size_t)vt_ld] = (bf16_t)(w.y >> 16);
                        vt[4 * (size_t)vt_ld] = (bf16_t)(w.z & 0xffffu); vt[5 * (size_t)vt_ld] = (bf16_t)(w.z >> 16);
                        vt[6 * (size_t)vt_ld] = (bf16_t)(w.w & 0xffffu); vt[7 * (size_t)vt_ld] = (bf16_t)(w.w >> 16);
                    } } }
    }
};
struct EpiRes {
    static constexpr bool PERM = false, AFTER_DRAIN = false;
    const float* base; float* out; int ldc; int pre_pm, pre_pn;
    __device__ __forceinline__ void operator()(const f32x4 (&acc)[2][2][4][2], const Unit& u, int wr, int wc, int fr, int fq) const {
        const int row0 = u.pm * BM + wr * 64 + fr, col0 = u.pn * BM + wc * 32 + 4 * fq;
        if (u.pm == pre_pm && u.pn == pre_pn) {
#pragma unroll
            for (int ai = 0; ai < 2; ++ai)
#pragma unroll
                for (int m = 0; m < 4; ++m) { const size_t off = (size_t)(row0 + ai * HALF + m * 16) * ldc + col0;
#pragma unroll
                    for (int bj = 0; bj < 2; ++bj)
#pragma unroll
                        for (int n = 0; n < 2; ++n) __builtin_nontemporal_store(acc[ai][bj][m][n], (f32x4*)(out + off + bj * HALF + n * 16)); }
            return;
        }
#pragma unroll
        for (int ai = 0; ai < 2; ++ai) {
            f32x4 xv[4][2][2];
#pragma unroll
            for (int m = 0; m < 4; ++m) { const size_t off = (size_t)(row0 + ai * HALF + m * 16) * ldc + col0;
#pragma unroll
                for (int bj = 0; bj < 2; ++bj)
#pragma unroll
                    for (int n = 0; n < 2; ++n) xv[m][bj][n] = *(const f32x4*)(base + off + bj * HALF + n * 16); }
#pragma unroll
            for (int m = 0; m < 4; ++m) { const size_t off = (size_t)(row0 + ai * HALF + m * 16) * ldc + col0;
#pragma unroll
                for (int bj = 0; bj < 2; ++bj)
#pragma unroll
                    for (int n = 0; n < 2; ++n) *(f32x4*)(out + off + bj * HALF + n * 16) = xv[m][bj][n] + acc[ai][bj][m][n]; }
        }
    }
};
template <class Epi, class Sched, bool ALIGN_EPI = false, bool SP2 = false, bool PRE = false>
__device__ __forceinline__ void gemm_phase(PG8_LAS unsigned char* lds, const Gemm g, const Sched& S, const Epi& E, f32x4 (&acc)[2][2][4][2]) {
    int tid_ = threadIdx.x; asm volatile("" : "+v"(tid_));
    const int tid = tid_, wid = __builtin_amdgcn_readfirstlane(tid >> 6), lane = tid & 63, wr = wid >> 2, wc = wid & 3, fr = lane & 15, fq = lane >> 4;
    const int K = g.K, nt = K / BK;
    unsigned voffA[2], voffB[2];
#pragma unroll
    for (int i = 0; i < 2; ++i) { int R, C; stage_rc(tid * 16 + i * 8192, R, C); const int Rb = Epi::PERM ? ((R & ~31) + perm32(R & 31)) : R;
        voffA[i] = (unsigned)(R * K + C) * 2u; voffB[i] = (unsigned)(Rb * K + C) * 2u; }
    const size_t kstep = (size_t)(BK * 2);
    const size_t hstep = (size_t)HALF * K * 2;
    const size_t tstep = 2 * hstep;
    const unsigned ldsw = (unsigned)wid * 1024u;
    const int aoff = lds_byte(wr * 64 + fr, fq * 8), boff = lds_byte(wc * 32 + fr, fq * 8);
#define PG8_SA(b, h) (((b) * 2 + (h)) * HTB)
#define PG8_SB(b, h) ((4 + (b) * 2 + (h)) * HTB)
#define PG8_STAGE(bufoff, gbase, voff) do { _Pragma("unroll") for (int _i = 0; _i < 2; ++_i) \
        __builtin_amdgcn_global_load_lds((const unsigned*)((const char*)(gbase) + (voff)[_i]), (PG8_LAS unsigned*)(lds + (bufoff) + ldsw + _i * 8192), 16, 0, 0); } while (0)
#define PG8_LDA(dst, b, h) do { _Pragma("unroll") for (int m = 0; m < 4; ++m) _Pragma("unroll") for (int k = 0; k < 2; ++k) dst[m][k] = *(const PG8_LAS bf16x8*)(lds + PG8_SA(b, h) + aoff + m * 2048 + k * 1024); } while (0)
#define PG8_LDB(dst, b, h) do { _Pragma("unroll") for (int n = 0; n < 2; ++n) _Pragma("unroll") for (int k = 0; k < 2; ++k) dst[n][k] = *(const PG8_LAS bf16x8*)(lds + PG8_SB(b, h) + boff + n * 2048 + k * 1024); } while (0)
#define PG8_MMA(ai, bj, At, Bt) do { __builtin_amdgcn_s_setprio(1); _Pragma("unroll") for (int m = 0; m < 4; ++m) _Pragma("unroll") for (int n = 0; n < 2; ++n) _Pragma("unroll") for (int k = 0; k < 2; ++k) \
        acc[ai][bj][m][n] = __builtin_amdgcn_mfma_f32_16x16x32_bf16(Bt[n][k], At[m][k], acc[ai][bj][m][n], 0, 0, 0); __builtin_amdgcn_s_setprio(0); } while (0)
#define PG8_WAIT_V(n) asm volatile("s_waitcnt vmcnt(" #n ")" ::: "memory")
#define PG8_WAIT_L(n) asm volatile("s_waitcnt lgkmcnt(" #n ")" ::: "memory")
#define PG8_BAR __builtin_amdgcn_s_barrier()
#define PG8_SCHED __builtin_amdgcn_sched_barrier(0)
    Unit cur, nxt; int ui = 0;
    if (!S.next(0, cur)) return;
#pragma unroll
    for (int a = 0; a < 2; ++a)
#pragma unroll
        for (int b = 0; b < 2; ++b)
#pragma unroll
            for (int m = 0; m < 4; ++m)
#pragma unroll
                for (int n = 0; n < 2; ++n) { if constexpr (PRE) asm volatile("" : "+v"(acc[a][b][m][n]));
                                              else acc[a][b][m][n] = (f32x4){0.f, 0.f, 0.f, 0.f}; }
    bf16x8 At[4][2], B0[2][2], B1[2][2];
    const char* cA = (const char*)g.A + (size_t)cur.pm * tstep; const char* cB = (const char*)g.Bt + (size_t)cur.pn * tstep;
    S.a_ready(cur);
    if constexpr (SP2) {
        PG8_STAGE(PG8_SB(0, 0), cB, voffB); PG8_STAGE(PG8_SB(0, 1), cB + hstep, voffB); PG8_STAGE(PG8_SA(0, 0), cA, voffA); PG8_STAGE(PG8_SA(0, 1), cA + hstep, voffA);
        if (wr == 1) PG8_BAR;
        PG8_WAIT_V(2); PG8_BAR;
        PG8_STAGE(PG8_SB(1, 0), cB + kstep, voffB); PG8_STAGE(PG8_SA(1, 0), cA + kstep, voffA); PG8_STAGE(PG8_SB(1, 1), cB + hstep + kstep, voffB);
        PG8_WAIT_V(6); PG8_BAR;
    } else {
        PG8_STAGE(PG8_SB(0, 0), cB, voffB); PG8_STAGE(PG8_SA(0, 0), cA, voffA); PG8_STAGE(PG8_SB(0, 1), cB + hstep, voffB); PG8_STAGE(PG8_SA(0, 1), cA + hstep, voffA);
        if (wr == 1) PG8_BAR;
        PG8_WAIT_V(4); PG8_BAR;
        PG8_STAGE(PG8_SB(1, 0), cB + kstep, voffB); PG8_STAGE(PG8_SA(1, 0), cA + kstep, voffA); PG8_STAGE(PG8_SB(1, 1), cB + hstep + kstep, voffB);
        PG8_WAIT_V(6); PG8_BAR;
    }
    for (;;) {
        const bool has_next = S.next(ui + 1, nxt);
        const char* nA = has_next ? (const char*)g.A + (size_t)nxt.pm * tstep : cA; const char* nB = has_next ? (const char*)g.Bt + (size_t)nxt.pn * tstep : cB;
        for (int t = 0; t < nt; t += 2) {
            const bool last = (t == nt - 2);
            const char* a1 = cA + (size_t)(t + 1) * kstep;
            const char* a2 = last ? nA : cA + (size_t)(t + 2) * kstep; const char* b2 = last ? nB : cB + (size_t)(t + 2) * kstep;
            const char* a3 = a2 + kstep; const char* b3 = b2 + kstep;
            if (last && has_next) S.a_ready(nxt);
            if constexpr (SP2) {
            PG8_LDB(B0, 0, 0); PG8_LDB(B1, 0, 1); PG8_SCHED; PG8_LDA(At, 0, 0); PG8_STAGE(PG8_SA(1, 1), a1 + hstep, voffA);
            PG8_WAIT_V(8); PG8_WAIT_L(0); PG8_BAR; PG8_MMA(0, 0, At, B0); PG8_MMA(0, 1, At, B1); PG8_BAR; PG8_SCHED;
            PG8_LDA(At, 0, 1); PG8_STAGE(PG8_SB(0, 0), b2, voffB); PG8_STAGE(PG8_SB(0, 1), b2 + hstep, voffB); PG8_STAGE(PG8_SA(0, 0), a2, voffA);
            PG8_WAIT_V(8); PG8_WAIT_L(0); PG8_BAR; PG8_MMA(1, 0, At, B0); PG8_MMA(1, 1, At, B1); PG8_BAR; PG8_SCHED;
            PG8_LDB(B0, 1, 0); PG8_LDB(B1, 1, 1); PG8_SCHED; PG8_LDA(At, 1, 0); PG8_STAGE(PG8_SA(0, 1), a2 + hstep, voffA);
            PG8_WAIT_V(8); PG8_WAIT_L(0); PG8_BAR; PG8_MMA(0, 0, At, B0); PG8_MMA(0, 1, At, B1); PG8_BAR; PG8_SCHED;
            PG8_LDA(At, 1, 1); PG8_STAGE(PG8_SB(1, 0), b3, voffB); PG8_STAGE(PG8_SB(1, 1), b3 + hstep, voffB); PG8_STAGE(PG8_SA(1, 0), a3, voffA);
            PG8_WAIT_V(8); PG8_WAIT_L(0); PG8_BAR; PG8_MMA(1, 0, At, B0); PG8_MMA(1, 1, At, B1); PG8_BAR; PG8_SCHED;
            } else {
            PG8_LDB(B0, 0, 0); PG8_SCHED; PG8_LDA(At, 0, 0); PG8_STAGE(PG8_SA(1, 1), a1 + hstep, voffA);
            PG8_WAIT_L(8); PG8_BAR; PG8_WAIT_L(0); PG8_MMA(0, 0, At, B0); PG8_BAR; PG8_SCHED;
            PG8_LDB(B1, 0, 1); PG8_STAGE(PG8_SB(0, 0), b2, voffB);
            PG8_BAR; PG8_WAIT_L(0); PG8_MMA(0, 1, At, B1); PG8_BAR;
            PG8_LDA(At, 0, 1); PG8_STAGE(PG8_SA(0, 0), a2, voffA);
            PG8_BAR; PG8_WAIT_L(0); PG8_MMA(1, 0, At, B0); PG8_BAR; PG8_SCHED;
            PG8_STAGE(PG8_SB(0, 1), b2 + hstep, voffB);
            PG8_WAIT_V(6); PG8_BAR; PG8_MMA(1, 1, At, B1); PG8_BAR;
            PG8_LDB(B0, 1, 0); PG8_SCHED; PG8_LDA(At, 1, 0); PG8_STAGE(PG8_SA(0, 1), a2 + hstep, voffA);
            PG8_WAIT_L(8); PG8_BAR; PG8_WAIT_L(0); PG8_MMA(0, 0, At, B0); PG8_BAR; PG8_SCHED;
            PG8_LDB(B1, 1, 1); PG8_STAGE(PG8_SB(1, 0), b3, voffB);
            PG8_BAR; PG8_WAIT_L(0); PG8_MMA(0, 1, At, B1); PG8_BAR;
            PG8_LDA(At, 1, 1); PG8_STAGE(PG8_SA(1, 0), a3, voffA);
            PG8_BAR; PG8_WAIT_L(0); PG8_MMA(1, 0, At, B0); PG8_BAR; PG8_SCHED;
            PG8_STAGE(PG8_SB(1, 1), b3 + hstep, voffB);
            PG8_WAIT_V(6); PG8_BAR; PG8_MMA(1, 1, At, B1); PG8_BAR;
            }
        }
        if constexpr (ALIGN_EPI) { if (wr == 0) PG8_BAR; }
        if constexpr (!Epi::AFTER_DRAIN) { E(acc, cur, wr, wc, fr, fq); S.done(cur); }
        if (!has_next) break;
#pragma unroll
        for (int a = 0; a < 2; ++a)
#pragma unroll
            for (int b = 0; b < 2; ++b)
#pragma unroll
                for (int m = 0; m < 4; ++m)
#pragma unroll
                    for (int n = 0; n < 2; ++n) acc[a][b][m][n] = (f32x4){0.f, 0.f, 0.f, 0.f};
        cur = nxt; cA = nA; cB = nB; ++ui;
        if constexpr (ALIGN_EPI) { if (wr == 1) PG8_BAR; }
    }
    PG8_WAIT_V(0);
    if constexpr (!ALIGN_EPI) { if (wr == 0) PG8_BAR; }
    PG8_BAR;
    if constexpr (Epi::AFTER_DRAIN) { E.fused(acc, cur, wr, wc, fr, fq, lds, wid, lane); S.done(cur); }
#undef PG8_SA
#undef PG8_SB
#undef PG8_STAGE
#undef PG8_LDA
#undef PG8_LDB
#undef PG8_MMA
#undef PG8_WAIT_V
#undef PG8_WAIT_L
#undef PG8_BAR
#undef PG8_SCHED
}
}

#define LAS __attribute__((address_space(3)))
#define XB_TMO      128
#define XB_XCNT(j)  (256  + 64 * (j))
#define XB_XSUB(j)  (1280 + 64 * (j))
#define XB_XGEN(j)  (2304 + 64 * (j))
#define XB_TOP      3328
#define XB_TOPGEN   3392
#define XCD_BAR_WORDS 3456
#define XB_SPIN_CAP (1u << 18)

__device__ __forceinline__ unsigned xb_ld(unsigned* p)              { return __hip_atomic_load(p, __ATOMIC_RELAXED, __HIP_MEMORY_SCOPE_AGENT); }
__device__ __forceinline__ unsigned xb_add(unsigned* p, unsigned v) { return __hip_atomic_fetch_add(p, v, __ATOMIC_RELAXED, __HIP_MEMORY_SCOPE_AGENT); }
__device__ __forceinline__ unsigned xb_xcc_id() { return (unsigned)__builtin_amdgcn_s_getreg((3 << 11) | 20) & 0xFu; }
#define XB_SPIN(cond, bar) do { unsigned _sp = 0; while (cond) { __builtin_amdgcn_s_sleep(1); \
    if ((++_sp & 255u) == 0u) { if (xb_ld(&(bar)[XB_TMO])) break; if (_sp > XB_SPIN_CAP) { atomicAdd(&(bar)[XB_TMO], 1u); break; } } } } while (0)

struct XcdBarrier {
    unsigned* bar; unsigned x;
    volatile LAS unsigned* st;
};

__device__ __forceinline__ XcdBarrier xcd_barrier_post(unsigned* bar, volatile LAS unsigned* st) {
    XcdBarrier b; b.bar = bar; b.x = xb_xcc_id(); b.st = st;
    if (threadIdx.x == 0) (void)xb_add(&bar[XB_XCNT(b.x)], 1u);
    return b;
}
__device__ __forceinline__ void xcd_barrier_complete(unsigned* bar, unsigned x, unsigned& nloc, unsigned& nx) {
    const unsigned G = gridDim.x * gridDim.y * gridDim.z;
    unsigned sum, cnt, mine, sp = 0u;
    for (;;) {
        sum = 0u; cnt = 0u; mine = 0u;
#pragma unroll
        for (unsigned j = 0; j < 16; ++j) { const unsigned c = xb_ld(&bar[XB_XCNT(j)]); sum += c; cnt += (c > 0u) ? 1u : 0u; mine = (j == x) ? c : mine; }
        if (sum == G) break;
        __builtin_amdgcn_s_sleep(1);
        if ((++sp & 255u) == 0u) { if (xb_ld(&bar[XB_TMO])) break; if (sp > XB_SPIN_CAP) { atomicAdd(&bar[XB_TMO], 1u); break; } }
    }
    nloc = mine > 0u ? mine : 1u; nx = cnt > 0u ? cnt : 1u;
}

__device__ __forceinline__ void xcd_barrier_protocol(const XcdBarrier& b) {
    {
        unsigned* bar = b.bar;
        __builtin_amdgcn_s_waitcnt(0);
        unsigned nloc = b.st[0], nx = b.st[1];
        if (nloc == 0u) { xcd_barrier_complete(bar, b.x, nloc, nx); b.st[0] = nloc; b.st[1] = nx; }
        const unsigned old = xb_add(&bar[XB_XSUB(b.x)], 1u);
        const unsigned gen = old / nloc;
        if (old + 1u == (gen + 1u) * nloc) {
            __builtin_amdgcn_fence(__ATOMIC_RELEASE, "agent");
            asm volatile("s_waitcnt vmcnt(0)" ::: "memory");
            const unsigned og = xb_add(&bar[XB_TOP], 1u);
            const unsigned tg = og / nx;
            if (og + 1u == (tg + 1u) * nx) xb_add(&bar[XB_TOPGEN], 1u);
            else XB_SPIN(xb_ld(&bar[XB_TOPGEN]) == tg, bar);
            __builtin_amdgcn_fence(__ATOMIC_ACQUIRE, "agent");
            xb_add(&bar[XB_XGEN(b.x)], 1u);
            asm volatile("s_waitcnt vmcnt(0)" ::: "memory");
        } else {
            XB_SPIN(xb_ld(&bar[XB_XGEN(b.x)]) == gen, bar);
            __builtin_amdgcn_fence(__ATOMIC_ACQUIRE, "agent");
            asm volatile("s_waitcnt vmcnt(0)" ::: "memory");
        }
    }
}
__device__ __forceinline__ void xcd_barrier(const XcdBarrier& b) {
    asm volatile("s_waitcnt vmcnt(0)" ::: "memory");
    __syncthreads();
    if (threadIdx.x == 0) xcd_barrier_protocol(b);
    __syncthreads();
}

typedef unsigned short bf16_t;
typedef short bf16x8 __attribute__((ext_vector_type(8)));
typedef short s16x4 __attribute__((ext_vector_type(4)));
typedef float f32x4 __attribute__((ext_vector_type(4)));
typedef float f32x16 __attribute__((ext_vector_type(16)));
typedef unsigned u32x4 __attribute__((ext_vector_type(4)));
typedef unsigned u32x2 __attribute__((ext_vector_type(2)));

constexpr int DM = 1024, SEQ = 16384, NSMP = 128, MP = 16640  , NZ = 2304;
constexpr int ZQ = 0, ZK = 512, ZV = 640, ZGA = 768, ZU = 1280, ZGP = 1792;
constexpr float EPS = 1e-6f, LOG2E = 1.4426950408889634f;
constexpr int LDS_CTL = 139264, LDS_BYTES = LDS_CTL + 64;
constexpr size_t WS_XB = 0;
constexpr size_t WS_RSTD = WS_XB + (size_t)MP * DM * 2;
constexpr size_t WS_WINT = WS_RSTD + (size_t)MP * 4;
constexpr size_t WS_WOUTT = WS_WINT + (size_t)NZ * DM * 2;
constexpr size_t WS_WPT = WS_WOUTT + (size_t)DM * DM * 2;
constexpr size_t WS_Z = WS_WPT + (size_t)4 * 128 * 128 * 2;
constexpr size_t WS_VT = WS_Z + (size_t)MP * NZ * 2;
constexpr size_t WS_MIX = WS_VT + (size_t)128 * MP * 2;
constexpr size_t WS_BAR = WS_MIX + (size_t)MP * DM * 2;
constexpr int BAR_WORDS = XCD_BAR_WORDS + 64 * 17;
constexpr size_t WS_END = WS_BAR + (size_t)BAR_WORDS * 4;
constexpr size_t O_YP = 0, O_YS = O_YP + (size_t)SEQ * DM, O_KP = O_YS + (size_t)NSMP * DM, O_VP = O_KP + 128 * 128, O_PP = O_VP + 128 * 128,
                 O_KS = O_PP + 15 * 512, O_VS = O_KS + (size_t)NSMP * 128 * 128, O_PS = O_VS + (size_t)NSMP * 128 * 128, O_END = O_PS + (size_t)NSMP * 15 * 512;

struct Args {
    const float *xp, *xs, *ck, *cv, *sp, *normw, *win, *qnw, *knw, *sinks, *wpool, *pscale, *wout;
    float* out; unsigned char* ws;
};

__device__ __forceinline__ float bf2f(unsigned b) { return __uint_as_float(b << 16); }
__device__ __forceinline__ unsigned pk2(float lo, float hi) { unsigned r; asm volatile("v_cvt_pk_bf16_f32 %0, %1, %2" : "=v"(r) : "v"(lo), "v"(hi)); return r; }
__device__ __forceinline__ float wave_sum(float v) {
#pragma unroll
    for (int o = 32; o > 0; o >>= 1) v += __shfl_xor(v, o);
    return v;
}
__device__ __forceinline__ float wave_max(float v) {
#pragma unroll
    for (int o = 32; o > 0; o >>= 1) v = fmaxf(v, __shfl_xor(v, o));
    return v;
}
__device__ __forceinline__ float silu(float x) { return x * __builtin_amdgcn_rcpf(1.0f + __expf(-x)); }
__device__ __forceinline__ void unpack8(const u32x4 w, float (&f)[8]) {
    f[0] = __uint_as_float(w.x << 16); f[1] = __uint_as_float(w.x & 0xffff0000u); f[2] = __uint_as_float(w.y << 16); f[3] = __uint_as_float(w.y & 0xffff0000u);
    f[4] = __uint_as_float(w.z << 16); f[5] = __uint_as_float(w.z & 0xffff0000u); f[6] = __uint_as_float(w.w << 16); f[7] = __uint_as_float(w.w & 0xffff0000u);
}

struct TileDesc { const float* src; bf16_t* dst; const float* kscale; const float* nscale; int K, N, k0, n0; };
__device__ __forceinline__ TileDesc tile_desc(const Args& a, int it) {
    constexpr int I_IN = 16 * 36, I_OUT = 16 * 16;
    TileDesc t;
    if (it < I_IN) { t.src = a.win; t.dst = (bf16_t*)(a.ws + WS_WINT); t.kscale = a.normw; t.nscale = nullptr; t.K = DM; t.N = NZ; t.k0 = (it & 15) * 64; t.n0 = (it >> 4) * 64; return t; }
    it -= I_IN;
    if (it < I_OUT) { t.src = a.wout; t.dst = (bf16_t*)(a.ws + WS_WOUTT); t.kscale = nullptr; t.nscale = nullptr; t.K = DM; t.N = DM; t.k0 = (it & 15) * 64; t.n0 = (it >> 4) * 64; return t; }
    it -= I_OUT;
    { const int g = it >> 2; t.src = a.wpool + g * 16384; t.dst = (bf16_t*)(a.ws + WS_WPT) + g * 16384; t.kscale = nullptr; t.nscale = a.pscale + g * 128; t.K = 128; t.N = 128; t.k0 = ((it >> 1) & 1) * 64; t.n0 = (it & 1) * 64; }
    return t;
}
__device__ __forceinline__ void p0_prologue(const Args& a, LAS unsigned char* lds) {
    int tid_ = threadIdx.x; asm volatile("" : "+v"(tid_)); const int tid = tid_, lane = tid & 63, wave = tid >> 6;
    bf16_t* XB = (bf16_t*)(a.ws + WS_XB);
    constexpr int NITEMS = 16 * 36 + 16 * 16 + 16;
    LAS float* scr = (LAS float*)lds;
    for (int it0 = blockIdx.x; it0 < NITEMS; it0 += 4 * gridDim.x) {
        f32x4 va[4], vb[4];
#pragma unroll
        for (int j = 0; j < 4; ++j) { const int it = it0 + j * gridDim.x;
            if (it < NITEMS) { const TileDesc t = tile_desc(a, it); const int kr = tid >> 3, c = tid & 7; const float* s = t.src + (size_t)(t.k0 + kr) * t.N + t.n0 + c * 8;
                va[j] = __builtin_nontemporal_load((const f32x4*)s); vb[j] = __builtin_nontemporal_load((const f32x4*)(s + 4));
                const float sc = t.kscale ? t.kscale[t.k0 + kr] : 1.0f; va[j] *= sc; vb[j] *= sc;
                if (t.nscale) { va[j] *= *(const f32x4*)(t.nscale + t.n0 + c * 8); vb[j] *= *(const f32x4*)(t.nscale + t.n0 + c * 8 + 4); } } }
#pragma unroll
        for (int j = 0; j < 4; ++j) { const int it = it0 + j * gridDim.x;
            if (it < NITEMS) { const TileDesc t = tile_desc(a, it);
                { const int kr = tid >> 3, c = tid & 7; LAS float* d = scr + kr * 65 + c * 8;
                  d[0] = va[j].x; d[1] = va[j].y; d[2] = va[j].z; d[3] = va[j].w; d[4] = vb[j].x; d[5] = vb[j].y; d[6] = vb[j].z; d[7] = vb[j].w; }
                __syncthreads();
                { const int n = tid >> 3, kc = tid & 7; const LAS float* sp = scr + (kc * 8) * 65 + n;
                  u32x4 o; o.x = pk2(sp[0], sp[65]); o.y = pk2(sp[130], sp[195]); o.z = pk2(sp[260], sp[325]); o.w = pk2(sp[390], sp[455]);
                  *(u32x4*)(t.dst + (size_t)(t.n0 + n) * t.K + t.k0 + kc * 8) = o; }
                __syncthreads(); } }
    }
    const int gw = blockIdx.x * 8 + wave, NGW = gridDim.x * 8;
    for (int m0 = gw; m0 < MP; m0 += 2 * NGW) {
        f32x4 v[2][4];
#pragma unroll
        for (int q = 0; q < 2; ++q) { const int m = m0 + q * NGW;
            if (m < SEQ + NSMP) { const float* xr = (m < SEQ) ? a.xp + (size_t)m * DM : a.xs + (size_t)(m - SEQ) * DM; const f32x4* x4 = (const f32x4*)xr + lane;
#pragma unroll
                for (int j = 0; j < 4; ++j) v[q][j] = __builtin_nontemporal_load(x4 + 64 * j); }
            else {
#pragma unroll
                for (int j = 0; j < 4; ++j) v[q][j] = (f32x4){0.f, 0.f, 0.f, 0.f}; } }
#pragma unroll
        for (int q = 0; q < 2; ++q) { const int m = m0 + q * NGW;
            if (m < MP) { float ss = 0.f;
#pragma unroll
                for (int j = 0; j < 4; ++j) ss += (v[q][j].x * v[q][j].x + v[q][j].y * v[q][j].y) + (v[q][j].z * v[q][j].z + v[q][j].w * v[q][j].w);
                ss = wave_sum(ss);
                const float rs = 1.0f / sqrtf(ss * (1.0f / DM) + EPS);
                unsigned long long* o8 = (unsigned long long*)(XB + (size_t)m * DM) + lane;
#pragma unroll
                for (int j = 0; j < 4; ++j) o8[64 * j] = (unsigned long long)pk2(v[q][j].x * rs, v[q][j].y * rs) | ((unsigned long long)pk2(v[q][j].z * rs, v[q][j].w * rs) << 32); } }
    }
}

constexpr int KS_STRIDE = 144, VS_STRIDE = 520, KS_OFF = 0, VS_OFF = 256 * KS_STRIDE;

__device__ __forceinline__ void attn_item(const Args& a, LAS unsigned char* lds, int qb, int kvh, int hsel) {
    int tid_ = threadIdx.x; asm volatile("" : "+v"(tid_)); const int tid = tid_, lane = tid & 63, wave = __builtin_amdgcn_readfirstlane(tid >> 6);
    const bf16_t* __restrict__ Z = (const bf16_t*)(a.ws + WS_Z); const bf16_t* __restrict__ VT = (const bf16_t*)(a.ws + WS_VT); bf16_t* __restrict__ MIX = (bf16_t*)(a.ws + WS_MIX);
    const int key_base = (qb - 1) * 128;
    const int head = kvh * 4 + ((hsel == 2) ? (wave >> 1) : (2 * hsel + (wave >> 2))), sb0 = (hsel == 2) ? 2 * (wave & 1) : (wave & 3), nsb = (hsel == 2) ? 2 : 1, r = lane & 31, h = lane >> 5;
    u32x4 kw[4], vw[4], qw[4];
#pragma unroll
    for (int i = 0; i < 4; ++i) { const int task = tid + 512 * i, kk = task >> 3, c = task & 7, pos = max(key_base + kk, 0);
        kw[i] = *(const u32x4*)(Z + (size_t)pos * NZ + ZK + kvh * 64 + c * 8); }
#pragma unroll
    for (int i = 0; i < 4; ++i) { const int task = tid + 512 * i, d = task >> 5, c = task & 31, pos = max(key_base + c * 8, 0);
        vw[i] = *(const u32x4*)(VT + (size_t)(kvh * 64 + d) * MP + pos); }
#pragma unroll
    for (int s = 0; s < 4; ++s) qw[s] = *(const u32x4*)(Z + (size_t)(qb * 128 + 32 * sb0 + r) * NZ + ZQ + head * 64 + 16 * s + 8 * h);
    u32x2 pvw[4];
    if (qb == 127) {
#pragma unroll
        for (int i = 0; i < 4; ++i) { const int idx = tid + 512 * i, t = idx >> 4, c4 = idx & 15; pvw[i] = *(const u32x2*)(Z + (size_t)(SEQ - 128 + t) * NZ + ZV + kvh * 64 + c4 * 4); }
    }
    const f32x4 kn0 = *(const f32x4*)(a.knw + (tid & 7) * 8), kn1 = *(const f32x4*)(a.knw + (tid & 7) * 8 + 4);
    const f32x4 kq0 = kn0 * *(const f32x4*)(a.qnw + (tid & 7) * 8), kq1 = kn1 * *(const f32x4*)(a.qnw + (tid & 7) * 8 + 4);
#pragma unroll
    for (int i = 0; i < 4; ++i) {
        const int task = tid + 512 * i, kk = task >> 3, c = task & 7;
        float f[8];
        u32x4 w = kw[i];
        if (key_base + kk < 0) w = (u32x4){0u, 0u, 0u, 0u};
        unpack8(w, f);
        float ss = 0.f;
#pragma unroll
        for (int j = 0; j < 8; ++j) ss += f[j] * f[j];
        ss += __shfl_xor(ss, 1); ss += __shfl_xor(ss, 2); ss += __shfl_xor(ss, 4);
        const float rr = 1.0f / sqrtf(ss * (1.0f / 64.0f) + EPS);
        if (qb == 127 && kk >= 128) {
            float* o = a.out + O_KP + (size_t)((kk - 128) * 2 + kvh) * 64 + c * 8;
            *(f32x4*)o = (f32x4){f[0] * rr * kn0.x, f[1] * rr * kn0.y, f[2] * rr * kn0.z, f[3] * rr * kn0.w}; *(f32x4*)(o + 4) = (f32x4){f[4] * rr * kn1.x, f[5] * rr * kn1.y, f[6] * rr * kn1.z, f[7] * rr * kn1.w};
        }
        f[0] *= rr * kq0.x; f[1] *= rr * kq0.y; f[2] *= rr * kq0.z; f[3] *= rr * kq0.w; f[4] *= rr * kq1.x; f[5] *= rr * kq1.y; f[6] *= rr * kq1.z; f[7] *= rr * kq1.w;
        u32x4 o; o.x = pk2(f[0], f[1]); o.y = pk2(f[2], f[3]); o.z = pk2(f[4], f[5]); o.w = pk2(f[6], f[7]);
        *(LAS u32x4*)(lds + KS_OFF + kk * KS_STRIDE + c * 16) = o;
    }
#pragma unroll
    for (int i = 0; i < 4; ++i) {
        const int task = tid + 512 * i, d = task >> 5, c = task & 31;
        u32x4 w = vw[i];
        if (key_base + c * 8 < 0) w = (u32x4){0u, 0u, 0u, 0u};
        LAS u32x2* p = (LAS u32x2*)(lds + VS_OFF + d * VS_STRIDE + c * 16);
        p[0] = (u32x2){w.x, w.y}; p[1] = (u32x2){w.z, w.w};
    }
    if (qb == 127) {
#pragma unroll
        for (int i = 0; i < 4; ++i) { const int idx = tid + 512 * i, t = idx >> 4, c4 = idx & 15; const u32x2 w = pvw[i];
            *(f32x4*)(a.out + O_VP + (size_t)(t * 2 + kvh) * 64 + c4 * 4) = (f32x4){__uint_as_float(w.x << 16), __uint_as_float(w.x & 0xffff0000u), __uint_as_float(w.y << 16), __uint_as_float(w.y & 0xffff0000u)}; }
    }
    __syncthreads();
    const float sink2 = a.sinks[head] * LOG2E;
#pragma unroll 1
    for (int sb = sb0; sb < sb0 + nsb; ++sb) {
        const int qs = qb * 128 + 32 * sb, row = qs + r;
        u32x4 qn[4];
        if (sb + 1 < sb0 + nsb) {
#pragma unroll
            for (int s = 0; s < 4; ++s) qn[s] = *(const u32x4*)(Z + (size_t)(qb * 128 + 32 * (sb + 1) + r) * NZ + ZQ + head * 64 + 16 * s + 8 * h);
        } else {
#pragma unroll
            for (int s = 0; s < 4; ++s) qn[s] = (u32x4){0u, 0u, 0u, 0u};
        }
        u32x4 gq[2][2];
#pragma unroll
        for (int dt = 0; dt < 2; ++dt)
#pragma unroll
            for (int kp = 0; kp < 2; ++kp) gq[dt][kp] = *(const u32x4*)(Z + (size_t)row * NZ + ZGA + head * 64 + dt * 32 + 16 * kp + 8 * h);
        bf16x8 qf[4];
        float rq;
        { float ss = 0.f;
#pragma unroll
          for (int s = 0; s < 4; ++s) { float f[8]; unpack8(qw[s], f); qf[s] = __builtin_bit_cast(bf16x8, qw[s]);
#pragma unroll
              for (int j = 0; j < 8; ++j) ss += f[j] * f[j]; }
          ss += __shfl_xor(ss, 32);
          rq = (1.0f / sqrtf(ss * (1.0f / 64.0f) + EPS)) * (0.125f * LOG2E); }
        const int kt0 = sb;
        f32x16 S[5];
        bf16x8 kf[2][4];
#pragma unroll
        for (int s = 0; s < 4; ++s) kf[0][s] = *(const LAS bf16x8*)(lds + KS_OFF + (kt0 * 32 + r) * KS_STRIDE + (16 * s + 8 * h) * 2);
#pragma unroll
        for (int i = 0; i < 5; ++i) {
            if (i + 1 < 5) {
#pragma unroll
                for (int s = 0; s < 4; ++s) kf[(i + 1) & 1][s] = *(const LAS bf16x8*)(lds + KS_OFF + ((kt0 + i + 1) * 32 + r) * KS_STRIDE + (16 * s + 8 * h) * 2);
            }
            const float s_init = (qb == 0 && kt0 + i < 4) ? -1e30f : 0.f;
#pragma unroll
            for (int e = 0; e < 16; ++e) S[i][e] = s_init;
            __builtin_amdgcn_sched_barrier(0);
#pragma unroll
            for (int s = 0; s < 4; ++s) S[i] = __builtin_amdgcn_mfma_f32_32x32x16_bf16(kf[i & 1][s], qf[s], S[i], 0, 0, 0);
            __builtin_amdgcn_sched_barrier(0);
        }
#pragma unroll
        for (int e = 0; e < 16; ++e) { const int rk = (e & 3) + 8 * (e >> 2) + 4 * h;
            S[0][e] = (rk >= r) ? S[0][e] : -1e30f; S[4][e] = (rk <= r) ? S[4][e] : -1e30f; }
        float mr = -1e30f;
#pragma unroll
        for (int i = 0; i < 5; ++i)
#pragma unroll
            for (int e = 0; e < 16; ++e) mr = fmaxf(mr, S[i][e]);
        mr = fmaxf(mr, __shfl_xor(mr, 32));
        const float mx = fmaxf(mr * rq, sink2);
        float l = 0.f;
#pragma unroll
        for (int i = 0; i < 5; ++i)
#pragma unroll
            for (int e = 0; e < 16; ++e) { const float p = __builtin_amdgcn_exp2f(__builtin_fmaf(S[i][e], rq, -mx)); S[i][e] = p; l += p; }
        l += __shfl_xor(l, 32);
        l += __builtin_amdgcn_exp2f(sink2 - mx);
        f32x16 O[2];
#pragma unroll
        for (int dt = 0; dt < 2; ++dt)
#pragma unroll
            for (int e = 0; e < 16; ++e) O[dt][e] = 0.f;
        bf16x8 vfr[4][2];
#define ATT_VREAD(T, DT) do { const LAS unsigned char* vp_ = lds + VS_OFF + ((DT) * 32 + r) * VS_STRIDE + ((kt0 + ((T) >> 1)) * 32 + 16 * ((T) & 1) + 4 * h) * 2; \
            const s16x4 v0_ = *(const LAS s16x4*)vp_, v1_ = *(const LAS s16x4*)(vp_ + 16); vfr[(T) & 3][DT] = __builtin_shufflevector(v0_, v1_, 0, 1, 2, 3, 4, 5, 6, 7); } while (0)
#pragma unroll
        for (int t = 0; t < 3; ++t) { ATT_VREAD(t, 0); ATT_VREAD(t, 1); }
#pragma unroll
        for (int t = 0; t < 10; ++t) {
            const int i = t >> 1, s2 = t & 1;
            if (t + 3 < 10) { ATT_VREAD(t + 3, 0); ATT_VREAD(t + 3, 1); }
            u32x4 pw; pw.x = pk2(S[i][8 * s2 + 0], S[i][8 * s2 + 1]); pw.y = pk2(S[i][8 * s2 + 2], S[i][8 * s2 + 3]);
            pw.z = pk2(S[i][8 * s2 + 4], S[i][8 * s2 + 5]); pw.w = pk2(S[i][8 * s2 + 6], S[i][8 * s2 + 7]);
            const bf16x8 pf = __builtin_bit_cast(bf16x8, pw);
            __builtin_amdgcn_sched_barrier(0);
            O[0] = __builtin_amdgcn_mfma_f32_32x32x16_bf16(vfr[t & 3][0], pf, O[0], 0, 0, 0);
            O[1] = __builtin_amdgcn_mfma_f32_32x32x16_bf16(vfr[t & 3][1], pf, O[1], 0, 0, 0);
            __builtin_amdgcn_sched_barrier(0);
        }
#undef ATT_VREAD
        const float inv = 1.0f / l;
#pragma unroll
        for (int dt = 0; dt < 2; ++dt)
#pragma unroll
            for (int kp = 0; kp < 2; ++kp) {
                u32x2 X = (u32x2){gq[dt][kp].x, gq[dt][kp].y}, Y = (u32x2){gq[dt][kp].z, gq[dt][kp].w};
                { auto r0 = __builtin_amdgcn_permlane32_swap(X.x, Y.x, false, false); X.x = r0[0]; Y.x = r0[1];
                  auto r1 = __builtin_amdgcn_permlane32_swap(X.y, Y.y, false, false); X.y = r1[0]; Y.y = r1[1]; }
                u32x2 o[2];
#pragma unroll
                for (int q = 0; q < 2; ++q) { const int g4 = 2 * kp + q; const u32x2 g = q ? Y : X;
                    const float g0 = __uint_as_float(g.x << 16), g1 = __uint_as_float(g.x & 0xffff0000u), g2 = __uint_as_float(g.y << 16), g3 = __uint_as_float(g.y & 0xffff0000u);
                    o[q].x = pk2(O[dt][4 * g4 + 0] * inv * g0, O[dt][4 * g4 + 1] * inv * g1);
                    o[q].y = pk2(O[dt][4 * g4 + 2] * inv * g2, O[dt][4 * g4 + 3] * inv * g3); }
                { auto r0 = __builtin_amdgcn_permlane32_swap(o[0].x, o[1].x, false, false); o[0].x = r0[0]; o[1].x = r0[1];
                  auto r1 = __builtin_amdgcn_permlane32_swap(o[0].y, o[1].y, false, false); o[0].y = r1[0]; o[1].y = r1[1]; }
                *(u32x4*)(MIX + (size_t)row * DM + head * 64 + dt * 32 + 16 * kp + 8 * h) = (u32x4){o[0].x, o[0].y, o[1].x, o[1].y};
            }
#pragma unroll
        for (int s = 0; s < 4; ++s) qw[s] = qn[s];
    }
    __syncthreads();
}

constexpr int PD_OFF = 0, PD_STRIDE = 528, PW_OFF = 128 * 528, PW_STRIDE = 272;
template <int WLEN>
__device__ __forceinline__ void window_pass(const u32x4 (&u)[23], LAS unsigned char* dst  , int tok0  ) {
    float s[8];
#pragma unroll
    for (int c = 0; c < 8; ++c) s[c] = 0.f;
#pragma unroll
    for (int j = 1; j < WLEN; ++j) { float f[8]; unpack8(u[15 - j], f);
#pragma unroll
        for (int c = 0; c < 8; ++c) s[c] += f[c]; }
#pragma unroll
    for (int tl = 0; tl < 8; ++tl) {
        float f[8], fo[8]; unpack8(u[15 + tl], f); unpack8(u[15 + tl - WLEN + 1], fo);
        const int cnt = min(WLEN, tok0 + tl + 1); const float ic = (cnt == WLEN) ? (1.0f / WLEN) : 1.0f / (float)cnt;
        float d[8];
#pragma unroll
        for (int c = 0; c < 8; ++c) { s[c] += f[c]; d[c] = s[c] * ic - f[c]; s[c] -= fo[c]; }
        u32x4 o; o.x = pk2(d[0], d[1]); o.y = pk2(d[2], d[3]); o.z = pk2(d[4], d[5]); o.w = pk2(d[6], d[7]);
        *(LAS u32x4*)(dst + tl * PD_STRIDE) = o;
    }
}
struct PoolRegs { u32x4 u[23]; u32x4 gq[2][2][2]; };
__device__ __forceinline__ void pool_load(const Args& a, int tile, int gp, PoolRegs& R) {
    int tid_ = threadIdx.x; asm volatile("" : "+v"(tid_)); const int tid = tid_, lane = tid & 63, wave = __builtin_amdgcn_readfirstlane(tid >> 6), fr = lane & 15, fq = lane >> 4;
    const bf16_t* __restrict__ Z = (const bf16_t*)(a.ws + WS_Z);
    const int t0 = tile * 128, gl = wave & 1, g = gp * 2 + gl, tb = (wave >> 1) * 32;
#pragma unroll
    for (int j = 0; j < 23; ++j) { const int pos = max(t0 + tb + 8 * (lane >> 4) - 15 + j, 0); R.u[j] = *(const u32x4*)(Z + (size_t)pos * NZ + ZU + g * 128 + (lane & 15) * 8); }
#pragma unroll
    for (int q = 0; q < 2; ++q)
#pragma unroll
        for (int m = 0; m < 2; ++m)
#pragma unroll
            for (int np = 0; np < 2; ++np) R.gq[q][m][np] = *(const u32x4*)(Z + (size_t)(t0 + tb + 16 * m + fr) * NZ + ZGP + (gp * 2 + q) * 128 + 64 * (wave & 1) + 16 * (2 * np + (fq & 1)) + 8 * (fq >> 1));
}
__device__ __forceinline__ void pool_item(const Args& a, LAS unsigned char* lds, int tile, int gp, PoolRegs& R) {
    int tid_ = threadIdx.x; asm volatile("" : "+v"(tid_)); const int tid = tid_, lane = tid & 63, wave = __builtin_amdgcn_readfirstlane(tid >> 6), fr = lane & 15, fq = lane >> 4;
    const bf16_t* __restrict__ WPT = (const bf16_t*)(a.ws + WS_WPT); bf16_t* __restrict__ MIX = (bf16_t*)(a.ws + WS_MIX);
    const int t0 = tile * 128;
    u32x4 ww[8];
#pragma unroll
    for (int i = 0; i < 8; ++i) { const int task = tid + 512 * i, rr = task >> 4, c = task & 15; ww[i] = *(const u32x4*)(WPT + (size_t)(gp * 2) * 16384 + rr * 128 + c * 8); }
    const int gl = wave & 1, g = gp * 2 + gl, tb = (wave >> 1) * 32;
    u32x4 (&u)[23] = R.u;
    const int sub = lane >> 4;
    if (tile == 0) {
#pragma unroll
        for (int j = 0; j < 15; ++j) if (tb + 8 * sub - 15 + j < 0) u[j] = (u32x4){0u, 0u, 0u, 0u};
    }
    const int row = t0 + wave * 16 + fr;
#pragma unroll
    for (int i = 0; i < 8; ++i) { const int task = tid + 512 * i, rr = task >> 4, c = task & 15; *(LAS u32x4*)(lds + PW_OFF + rr * PW_STRIDE + c * 16) = ww[i]; }
    { LAS unsigned char* dst = lds + PD_OFF + (tb + 8 * sub) * PD_STRIDE + gl * 256 + (lane & 15) * 16; const int tok0 = (tile == 0) ? tb + 8 * sub : 1000000;
      if (g == 0) window_pass<2>(u, dst, tok0); else if (g == 1) window_pass<4>(u, dst, tok0); else if (g == 2) window_pass<8>(u, dst, tok0); else window_pass<16>(u, dst, tok0); }
    if (tile == 127 && tb == 96 && sub >= 2) {
#pragma unroll
        for (int tl = 0; tl < 8; ++tl) { const int i = 96 + 8 * sub + tl - 113;
            if (i >= 0) { float f[8]; unpack8(u[15 + tl], f); float* o = a.out + O_PP + (size_t)i * 512 + g * 128 + (lane & 15) * 8;
                *(f32x4*)o = (f32x4){f[0], f[1], f[2], f[3]}; *(f32x4*)(o + 4) = (f32x4){f[4], f[5], f[6], f[7]}; } }
    }
    __syncthreads();
    f32x4 acc[2][8];
#pragma unroll
    for (int q = 0; q < 2; ++q)
#pragma unroll
        for (int n = 0; n < 8; ++n) acc[q][n] = (f32x4){0.f, 0.f, 0.f, 0.f};
    const int ddh = wave & 1;
    bf16x8 fa[2][2], fb[2][4];
#define POOL_FRAGS(T) do { const int q_ = (T) >> 2, kk_ = (T) & 3; \
        _Pragma("unroll") for (int m = 0; m < 2; ++m) fa[(T) & 1][m] = *(const LAS bf16x8*)(lds + PD_OFF + (tb + 16 * m + fr) * PD_STRIDE + q_ * 256 + (32 * kk_ + 8 * fq) * 2); \
        _Pragma("unroll") for (int n = 0; n < 4; ++n) fb[(T) & 1][n] = *(const LAS bf16x8*)(lds + PW_OFF + (q_ * 128 + 64 * ddh + 16 * n + fr) * PW_STRIDE + (32 * kk_ + 8 * fq) * 2); } while (0)
    POOL_FRAGS(0);
#pragma unroll
    for (int t = 0; t < 8; ++t) {
        if (t + 1 < 8) POOL_FRAGS(t + 1);
        __builtin_amdgcn_sched_barrier(0);
#pragma unroll
        for (int n = 0; n < 4; ++n)
#pragma unroll
            for (int m = 0; m < 2; ++m) acc[t >> 2][4 * m + n] = __builtin_amdgcn_mfma_f32_16x16x32_bf16(fb[t & 1][n], fa[t & 1][m], acc[t >> 2][4 * m + n], 0, 0, 0);
        __builtin_amdgcn_sched_barrier(0);
    }
#undef POOL_FRAGS
#pragma unroll
    for (int q = 0; q < 2; ++q)
#pragma unroll
        for (int m = 0; m < 2; ++m)
#pragma unroll
            for (int np = 0; np < 2; ++np) {
                const u32x4 gq = R.gq[q][m][np];
                u32x2 X = (u32x2){gq.x, gq.y}, Y = (u32x2){gq.z, gq.w};
                { auto r0 = __builtin_amdgcn_permlane16_swap(X.x, Y.x, false, false); X.x = r0[0]; Y.x = r0[1];
                  auto r1 = __builtin_amdgcn_permlane16_swap(X.y, Y.y, false, false); X.y = r1[0]; Y.y = r1[1]; }
                u32x2 o[2];
#pragma unroll
                for (int e = 0; e < 2; ++e) { const u32x2 gv = e ? Y : X; const f32x4 y = acc[q][4 * m + 2 * np + e];
                    const float g0 = __uint_as_float(gv.x << 16), g1 = __uint_as_float(gv.x & 0xffff0000u), g2 = __uint_as_float(gv.y << 16), g3 = __uint_as_float(gv.y & 0xffff0000u);
                    o[e].x = pk2(y.x * g0, y.y * g1); o[e].y = pk2(y.z * g2, y.w * g3); }
                { auto r0 = __builtin_amdgcn_permlane16_swap(o[0].x, o[1].x, false, false); o[0].x = r0[0]; o[1].x = r0[1];
                  auto r1 = __builtin_amdgcn_permlane16_swap(o[0].y, o[1].y, false, false); o[0].y = r1[0]; o[1].y = r1[1]; }
                *(u32x4*)(MIX + (size_t)(t0 + tb + 16 * m + fr) * DM + 512 + (gp * 2 + q) * 128 + 64 * ddh + 16 * (2 * np + (fq & 1)) + 8 * (fq >> 1)) = (u32x4){o[0].x, o[0].y, o[1].x, o[1].y};
            }
    __syncthreads();
}

struct SampleRegs { f32x4 kv[4], vv[4]; float spv[15]; float un, newv; };
__device__ __forceinline__ void sample_load(const Args& a, int b, int half, SampleRegs& R) {
    int tid_ = threadIdx.x; asm volatile("" : "+v"(tid_)); const int tid = tid_, lane = tid & 63, wave = __builtin_amdgcn_readfirstlane(tid >> 6);
    const bf16_t* __restrict__ Z = (const bf16_t*)(a.ws + WS_Z); const bf16_t* zrow = Z + (size_t)(SEQ + b) * NZ; const int kvh = half;
#pragma unroll
    for (int i = 0; i < 4; ++i) { const int idx = tid + 512 * i, key = idx >> 4, c4 = idx & 15; const size_t src = ((size_t)(b * 128 + key) * 2 + kvh) * 64 + c4 * 4;
        R.kv[i] = __builtin_nontemporal_load((const f32x4*)(a.ck + src)); R.vv[i] = __builtin_nontemporal_load((const f32x4*)(a.cv + src)); }
    const int pt = tid & 255, pgl = pt >> 7, pc = pt & 127, pg = half * 2 + pgl, pch = pg * 128 + pc;
    R.un = 0.f;
#pragma unroll
    for (int i = 0; i < 15; ++i) R.spv[i] = 0.f;
    if (tid >= 256) {
#pragma unroll
        for (int i = 0; i < 15; ++i) R.spv[i] = __builtin_nontemporal_load(a.sp + ((size_t)b * 15 + i) * 512 + pch);
        R.un = bf2f(zrow[ZU + pch]);
    }
    R.newv = 0.f;
    if (wave == 0) R.newv = bf2f(zrow[ZK + kvh * 64 + lane]); else if (wave == 1) R.newv = bf2f(zrow[ZV + kvh * 64 + lane]); else if (wave < 6) R.newv = bf2f(zrow[ZQ + (kvh * 4 + wave - 2) * 64 + lane]);
}
__device__ __forceinline__ void sample_item(const Args& a, LAS unsigned char* lds, int b, int half, const SampleRegs& R) {
    int tid_ = threadIdx.x; asm volatile("" : "+v"(tid_)); const int tid = tid_, lane = tid & 63, wave = __builtin_amdgcn_readfirstlane(tid >> 6), fr = lane & 15, fq = lane >> 4;
    const bf16_t* __restrict__ Z = (const bf16_t*)(a.ws + WS_Z); const bf16_t* __restrict__ WPT = (const bf16_t*)(a.ws + WS_WPT); bf16_t* __restrict__ MIX = (bf16_t*)(a.ws + WS_MIX);
    const bf16_t* zrow = Z + (size_t)(SEQ + b) * NZ; bf16_t* mrow = MIX + (size_t)(SEQ + b) * DM;
    LAS float* Kc = (LAS float*)lds;
    LAS float* Vc = Kc + 129 * 65 + 3;
    LAS float* qs = Vc + 129 * 64;
    LAS bf16_t* dvb = (LAS bf16_t*)(qs + 256);
    const int kvh = half;
    const int pt = tid & 255, pgl = pt >> 7, pc = pt & 127, pg = half * 2 + pgl, pch = pg * 128 + pc;
    const f32x4 (&kv)[4] = R.kv; const f32x4 (&vv)[4] = R.vv; const float (&spv)[15] = R.spv; const float un = R.un, newv = R.newv;
    bf16x8 wfr[4][4];
    if (wave >= 4) {
#pragma unroll
        for (int t = 0; t < 4; ++t) { const int nt = (wave - 4) * 4 + t, q = nt >> 3, n = nt & 7;
#pragma unroll
            for (int kk = 0; kk < 4; ++kk) wfr[t][kk] = *(const bf16x8*)(WPT + (size_t)(half * 2 + q) * 16384 + (16 * n + fr) * 128 + 32 * kk + 8 * fq); }
    }
#pragma unroll
    for (int i = 0; i < 4; ++i) { const int idx = tid + 512 * i, key = idx >> 4, c4 = idx & 15;
        LAS float* kd = Kc + key * 65 + c4 * 4; kd[0] = kv[i].x; kd[1] = kv[i].y; kd[2] = kv[i].z; kd[3] = kv[i].w;
        *(LAS f32x4*)(Vc + key * 64 + c4 * 4) = vv[i];
        if (key >= 1) { const size_t dst = ((size_t)(b * 128 + key - 1) * 2 + kvh) * 64 + c4 * 4; __builtin_nontemporal_store(kv[i], (f32x4*)(a.out + O_KS + dst)); __builtin_nontemporal_store(vv[i], (f32x4*)(a.out + O_VS + dst)); } }
    if (wave == 0) { const float ss = wave_sum(newv * newv); const float kn = newv * (1.0f / sqrtf(ss * (1.0f / 64.0f) + EPS)) * a.knw[lane];
        Kc[128 * 65 + lane] = kn; a.out[O_KS + ((size_t)(b * 128 + 127) * 2 + kvh) * 64 + lane] = kn; }
    else if (wave == 1) { Vc[128 * 64 + lane] = newv; a.out[O_VS + ((size_t)(b * 128 + 127) * 2 + kvh) * 64 + lane] = newv; }
    else if (wave < 6) { const float ss = wave_sum(newv * newv); qs[(wave - 2) * 64 + lane] = newv * (1.0f / sqrtf(ss * (1.0f / 64.0f) + EPS)) * a.qnw[lane] * 0.125f; }
    if (tid >= 256) { const int wlen = 2 << pg; float s = un; float* po = a.out + O_PS + (size_t)b * 15 * 512 + pch;
#pragma unroll
        for (int i = 0; i < 15; ++i) { if (i >= 16 - wlen) s += spv[i]; if (i >= 1) __builtin_nontemporal_store(spv[i], po + (size_t)(i - 1) * 512); }
        po[(size_t)14 * 512] = un;
        dvb[pgl * 128 + pc] = (bf16_t)(pk2(s / (float)wlen - un, 0.f) & 0xffffu); }
    __syncthreads();
    if (wave < 4) { const int hl = wave; const float sink = a.sinks[kvh * 4 + hl];
        const int col = (kvh * 4 + hl) * 64 + lane; const float ga = bf2f(zrow[ZGA + col]);
        float s0 = 0.f, s1 = 0.f, s2 = 0.f;
#pragma unroll 16
        for (int d = 0; d < 64; ++d) { const float q = qs[hl * 64 + d]; s0 += q * Kc[lane * 65 + d]; s1 += q * Kc[(lane + 64) * 65 + d]; s2 += q * Kc[128 * 65 + d]; }
        const float m = fmaxf(fmaxf(wave_max(fmaxf(s0, s1)), s2), sink);
        const float p0 = __expf(s0 - m), p1 = __expf(s1 - m), p2 = __expf(s2 - m);
        const float inv = 1.0f / (wave_sum(p0 + p1) + p2 + __expf(sink - m));
        float o = p2 * Vc[128 * 64 + lane];
#pragma unroll
        for (int key = 0; key < 64; ++key) { o += __uint_as_float(__builtin_amdgcn_readlane(__float_as_uint(p0), key)) * Vc[key * 64 + lane]; o += __uint_as_float(__builtin_amdgcn_readlane(__float_as_uint(p1), key)) * Vc[(key + 64) * 64 + lane]; }
        mrow[col] = (bf16_t)(pk2(o * inv * ga, 0.f) & 0xffffu); }
    else {
        f32x4 acc[4];
#pragma unroll
        for (int t = 0; t < 4; ++t) acc[t] = (f32x4){0.f, 0.f, 0.f, 0.f};
#pragma unroll
        for (int t = 0; t < 4; ++t) { const int nt = (wave - 4) * 4 + t, q = nt >> 3;
#pragma unroll
            for (int kk = 0; kk < 4; ++kk) { bf16x8 af = *(const LAS bf16x8*)(dvb + q * 128 + 32 * kk + 8 * fq);
                if (fr != 0) af = (bf16x8){0, 0, 0, 0, 0, 0, 0, 0};
                acc[t] = __builtin_amdgcn_mfma_f32_16x16x32_bf16(wfr[t][kk], af, acc[t], 0, 0, 0); } }
        if (fr == 0) {
#pragma unroll
            for (int t = 0; t < 4; ++t) { const int nt = (wave - 4) * 4 + t, q = nt >> 3, n = nt & 7, col = (half * 2 + q) * 128 + 16 * n + 4 * fq;
                const u32x2 gv = *(const u32x2*)(zrow + ZGP + col);
                const float g0 = __uint_as_float(gv.x << 16), g1 = __uint_as_float(gv.x & 0xffff0000u), g2 = __uint_as_float(gv.y << 16), g3 = __uint_as_float(gv.y & 0xffff0000u);
                u32x2 o; o.x = pk2(acc[t].x * g0, acc[t].y * g1); o.y = pk2(acc[t].z * g2, acc[t].w * g3);
                *(u32x2*)(mrow + 512 + col) = o; } }
    }
    __syncthreads();
}

__device__ __forceinline__ void sample_out_piece(const Args& a, LAS unsigned char* lds, int piece) {
    int tid_ = threadIdx.x; asm volatile("" : "+v"(tid_)); const int tid = tid_, lane = tid & 63, wave = __builtin_amdgcn_readfirstlane(tid >> 6), fr = lane & 15, fq = lane >> 4;
    const bf16_t* MIX = (const bf16_t*)(a.ws + WS_MIX); const bf16_t* WOUTT = (const bf16_t*)(a.ws + WS_WOUTT);
    const int pr = piece >> 5, pc = piece & 31;
    f32x4 acc[2] = {(f32x4){0.f, 0.f, 0.f, 0.f}, (f32x4){0.f, 0.f, 0.f, 0.f}};
#pragma unroll
    for (int kk = 0; kk < 4; ++kk) { const int k = wave * 128 + kk * 32 + fq * 8;
        const bf16x8 af = *(const bf16x8*)(MIX + (size_t)(SEQ + pr * 16 + fr) * DM + k);
#pragma unroll
        for (int n = 0; n < 2; ++n) { const bf16x8 bfr = *(const bf16x8*)(WOUTT + (size_t)(pc * 32 + n * 16 + fr) * DM + k);
            acc[n] = __builtin_amdgcn_mfma_f32_16x16x32_bf16(bfr, af, acc[n], 0, 0, 0); } }
    LAS f32x4* red = (LAS f32x4*)lds;
    red[(wave * 2 + 0) * 64 + lane] = acc[0]; red[(wave * 2 + 1) * 64 + lane] = acc[1];
    __syncthreads();
    if (tid < 128) { const int n = tid >> 6; f32x4 s = (f32x4){0.f, 0.f, 0.f, 0.f};
#pragma unroll
        for (int w = 0; w < 8; ++w) s += red[(w * 2 + n) * 64 + lane];
        const size_t off = (size_t)(pr * 16 + fr) * DM + pc * 32 + n * 16 + 4 * fq;
        *(f32x4*)(a.out + O_YS + off) = *(const f32x4*)(a.xs + off) + s; }
    __syncthreads();
}

__device__ __forceinline__ void preload_x(const float* __restrict__ xp, int pm, int pn, pg8::f32x4 (&acc)[2][2][4][2]) {
    if (pm < 0) return;
    const int t = threadIdx.x, wid = t >> 6, lane = t & 63, wr = wid >> 2, wc = wid & 3, fr = lane & 15, fq = lane >> 4;
    const int row0 = pm * 256 + wr * 64 + fr, col0 = pn * 256 + wc * 32 + 4 * fq;
#pragma unroll
    for (int ai = 0; ai < 2; ++ai)
#pragma unroll
        for (int m = 0; m < 4; ++m) { const size_t off = (size_t)(row0 + ai * 128 + m * 16) * DM + col0;
#pragma unroll
            for (int bj = 0; bj < 2; ++bj)
#pragma unroll
                for (int n = 0; n < 2; ++n) acc[ai][bj][m][n] = __builtin_nontemporal_load((const pg8::f32x4*)(xp + off + bj * 128 + n * 16)); }
}
struct Order1 {
    static constexpr int NUNITS = 65 * 9;
    int G, c; unsigned* cnt; int s_pm, s_pn; unsigned xcc, nloc;
    __device__ __forceinline__ bool next(int i, pg8::Unit& u) const {
        const int L = i * G + c; if (L >= NUNITS) return false;
        if (L < 512) { pg8::StaticOrder T; T.init(64 * 256, 8 * 256, 512, L); T.next(0, u);
            if (L >= 256) { u.pn = 4 + ((u.pn - 4 + 2) & 3); if (u.pn == 6) u.pn = 8; }
            return true; }
        const int j = L - 512; if (j < 64) { u.pm = j; u.pn = 6; } else { u.pm = 64; u.pn = j - 64; }
        return true;
    }
    __device__ __forceinline__ void init(int G_, int c_, unsigned* cnt_, unsigned xcc_, unsigned nloc_) { G = G_; c = c_; cnt = cnt_; xcc = xcc_; nloc = nloc_; s_pm = -1; s_pn = -1; pg8::Unit u; if (next(1, u)) { s_pm = u.pm; s_pn = u.pn; } }
    __device__ __forceinline__ void a_ready(const pg8::Unit&) const {}
    __device__ __forceinline__ void done(const pg8::Unit& u) const {
        if (cnt != nullptr && u.pm == s_pm && u.pn == s_pn) {
            asm volatile("s_waitcnt vmcnt(0)" ::: "memory");
            if ((threadIdx.x & 63) == 0) {
                const unsigned old = __hip_atomic_fetch_add(cnt + 64 * xcc, 1u, __ATOMIC_RELAXED, __HIP_MEMORY_SCOPE_AGENT);
                if (old + 1u == 8u * nloc) {
                    __builtin_amdgcn_fence(__ATOMIC_RELEASE, "agent");
                    asm volatile("s_waitcnt vmcnt(0)" ::: "memory");
                    __hip_atomic_fetch_add(cnt + 64 * 16, 1u, __ATOMIC_RELAXED, __HIP_MEMORY_SCOPE_AGENT);
                }
            }
        }
    }
};

template <int PH>
__global__ void __launch_bounds__(512, 2) mk_fwd(Args a) {
    extern __shared__ __attribute__((aligned(16))) unsigned char lds_raw[];
    LAS unsigned char* lds = (LAS unsigned char*)lds_raw;
    const int G = gridDim.x;
    const bool early = (G == 256);
    unsigned* const early_cnt = (unsigned*)(a.ws + WS_BAR) + XCD_BAR_WORDS;
    XcdBarrier bar; bar.bar = (unsigned*)(a.ws + WS_BAR); bar.x = 0; bar.st = nullptr;
    if (PH < 0) {
        if (threadIdx.x < 16) ((LAS unsigned*)(lds + LDS_CTL))[threadIdx.x] = 0u;
        __syncthreads();
        bar = xcd_barrier_post((unsigned*)(a.ws + WS_BAR), (volatile LAS unsigned*)(lds + LDS_CTL));
    }
    if (PH < 0 || PH == 0) { p0_prologue(a, lds); }
    if (PH < 0) { xcd_barrier(bar); }
    if (PH < 0 || PH == 1) {
        pg8::Gemm g{(const pg8::bf16_t*)(a.ws + WS_XB), (const pg8::bf16_t*)(a.ws + WS_WINT), MP, NZ, DM};
        Order1 S; S.init(G, (int)blockIdx.x, (PH < 0 && early) ? early_cnt : nullptr, bar.x, (PH < 0) ? bar.st[0] : 1u);
        pg8::EpiZ E{(pg8::bf16_t*)(a.ws + WS_Z), NZ, (const float*)(a.ws + WS_RSTD), (pg8::bf16_t*)(a.ws + WS_VT), MP};
        pg8::f32x4 acc[2][2][4][2];
        pg8::gemm_phase<pg8::EpiZ, Order1, true, true, false>(lds, g, S, E, acc);
        {
            const int nwg = Order1::NUNITS, rounds = (nwg + G - 1) / G, busy = nwg - (rounds - 1) * G;
            if (PH < 0 && early) {
                if ((int)blockIdx.x >= busy) {
                    if (threadIdx.x == 0) { unsigned sp = 0u; while (xb_ld(early_cnt + 64 * 16) < bar.st[1]) { __builtin_amdgcn_s_sleep(2); if (++sp > (1u << 22)) break; }
                        __builtin_amdgcn_fence(__ATOMIC_ACQUIRE, "agent"); asm volatile("s_waitcnt vmcnt(0)" ::: "memory"); }
                    __syncthreads();
                    const int j = (int)blockIdx.x - busy, nidle = G - busy;
                    if (j < 256) attn_item(a, lds, j >> 1, j & 1, 2);
                    for (int hj = j; hj < 2 * (256 - nidle); hj += nidle) { const int it = nidle + (hj >> 1); attn_item(a, lds, it >> 1, it & 1, hj & 1); }
                }
            }
        }
    }
    if (PH < 0) { xcd_barrier(bar); }
    if (PH < 0 || PH == 2) {
        for (int it = blockIdx.x; it < 256; it += G) {
            if (!(PH < 0 && early)) attn_item(a, lds, it >> 1, it & 1, 2);
            SampleRegs R; sample_load(a, it >> 1, it & 1, R);
            sample_item(a, lds, it >> 1, it & 1, R);
            PoolRegs PR; pool_load(a, it >> 1, it & 1, PR);
            pool_item(a, lds, it >> 1, it & 1, PR);
        }
    }
    pg8::f32x4 acc3[2][2][4][2];
    pg8::Unit u3; u3.pm = -1; u3.pn = -1;
    if (PH < 0) {
        pg8::StaticOrder S3; S3.init(SEQ, DM, G, (int)blockIdx.x); const bool has3 = S3.next(0, u3); if (!has3) { u3.pm = -1; u3.pn = -1; }
        asm volatile("s_waitcnt vmcnt(0)" ::: "memory");
        __syncthreads();
        if (threadIdx.x >= 64) preload_x(a.xp, u3.pm, u3.pn, acc3);
        if (threadIdx.x == 0) xcd_barrier_protocol(bar);
        if (threadIdx.x < 64) preload_x(a.xp, u3.pm, u3.pn, acc3);
        __syncthreads();
    }
    if (PH < 0 || PH == 3) {
        pg8::Gemm g{(const pg8::bf16_t*)(a.ws + WS_MIX), (const pg8::bf16_t*)(a.ws + WS_WOUTT), SEQ, DM, DM};
        pg8::StaticOrder S; S.init(SEQ, DM, G, (int)blockIdx.x);
        pg8::EpiRes E{a.xp, a.out + O_YP, DM, u3.pm, u3.pn};
        pg8::gemm_phase<pg8::EpiRes, pg8::StaticOrder, true, true, (PH < 0)>(lds, g, S, E, acc3);
        __syncthreads();
        for (int piece = blockIdx.x; piece < 256; piece += G) sample_out_piece(a, lds, piece);
    }
}

extern "C" void kernel_launch(void* const* d_in, const int* in_sizes, int n_in, void* d_out, int out_size, void* d_ws, size_t ws_size, hipStream_t stream) {
    static int grid = 0;
    if (grid == 0) {
        if (n_in != 13 || (size_t)out_size != O_END || ws_size < WS_END) { fprintf(stderr, "kernel_launch: unexpected shapes (n_in %d out %d ws %zu)\n", n_in, out_size, ws_size); grid = -1; return; }
        int dev = 0, cus = 0, per_cu = 0;
        hipGetDevice(&dev); hipDeviceGetAttribute(&cus, hipDeviceAttributeMultiprocessorCount, dev);
#if ONE_LAUNCH
        hipFuncSetAttribute((const void*)mk_fwd<-1>, hipFuncAttributeMaxDynamicSharedMemorySize, LDS_BYTES);
        hipOccupancyMaxActiveBlocksPerMultiprocessor(&per_cu, (const void*)mk_fwd<-1>, 512, LDS_BYTES);
#else
        hipFuncSetAttribute((const void*)mk_fwd<0>, hipFuncAttributeMaxDynamicSharedMemorySize, LDS_BYTES);
        hipFuncSetAttribute((const void*)mk_fwd<1>, hipFuncAttributeMaxDynamicSharedMemorySize, LDS_BYTES);
        hipFuncSetAttribute((const void*)mk_fwd<2>, hipFuncAttributeMaxDynamicSharedMemorySize, LDS_BYTES);
        hipFuncSetAttribute((const void*)mk_fwd<3>, hipFuncAttributeMaxDynamicSharedMemorySize, LDS_BYTES);
        per_cu = 1;
#endif
        if (per_cu < 1 || cus < 1) { fprintf(stderr, "kernel_launch: occupancy query gives %d blocks/CU on %d CUs\n", per_cu, cus); grid = -1; return; }
        grid = cus;
    }
    if (grid < 0) return;
    Args a{};
    a.xp = (const float*)d_in[0]; a.xs = (const float*)d_in[1]; a.ck = (const float*)d_in[2]; a.cv = (const float*)d_in[3]; a.sp = (const float*)d_in[4];
    a.normw = (const float*)d_in[5]; a.win = (const float*)d_in[6]; a.qnw = (const float*)d_in[7]; a.knw = (const float*)d_in[8]; a.sinks = (const float*)d_in[9];
    a.wpool = (const float*)d_in[10]; a.pscale = (const float*)d_in[11]; a.wout = (const float*)d_in[12];
    a.out = (float*)d_out; a.ws = (unsigned char*)d_ws;
#if ONE_LAUNCH
    hipMemsetAsync((char*)d_ws + WS_BAR, 0, (size_t)BAR_WORDS * 4, stream);
    void* args[] = {&a};
    hipError_t e = hipLaunchCooperativeKernel((const void*)mk_fwd<-1>, dim3(grid), dim3(512), args, LDS_BYTES, stream);
    if (e != hipSuccess) fprintf(stderr, "cooperative launch failed: %s (grid %d)\n", hipGetErrorString(e), grid);
#else
    hipLaunchKernelGGL(mk_fwd<0>, dim3(grid), dim3(512), LDS_BYTES, stream, a);
    hipLaunchKernelGGL(mk_fwd<1>, dim3(grid), dim3(512), LDS_BYTES, stream, a);
    hipLaunchKernelGGL(mk_fwd<2>, dim3(grid), dim3(512), LDS_BYTES, stream, a);
    hipLaunchKernelGGL(mk_fwd<3>, dim3(grid), dim3(512), LDS_BYTES, stream, a);
#endif
}
```
